# Optimizing an MI355X kernel written in HIP

```python
import math
import jax
import jax.numpy as jnp
from jax import lax
import numpy as np

D_MODEL = 1024
BATCH = 8
SEQ = 8192
DEPTH = 2

ROPE_THETA = 10000.0
NORM_EPS = 1e-6
Q_BLOCK = 128
NEG_INF = -1e30
N_BRANCHES = 3

DIFF_HEADS = 4
DIFF_HEAD_DIM = 64
DIFF_V_DIM = 2 * DIFF_HEAD_DIM
DIFF_WIDTH = DIFF_HEADS * DIFF_V_DIM

DIL_PATTERNS = ((128, 1), (512, 4), (2048, 16))
DIL_HEADS = 4
DIL_HEAD_DIM = 64
DIL_WIDTH = DIL_HEADS * DIL_HEAD_DIM

MLA_HEADS = 8
MLA_NOPE_DIM = 64
MLA_ROPE_DIM = 32
MLA_V_DIM = 64
MLA_Q_LORA = 768
MLA_KV_LORA = 256
MLA_WIDTH = MLA_HEADS * MLA_V_DIM

MLP_HIDDEN = 4 * D_MODEL

IN_COLS = (2 * DIFF_HEADS * 2 * DIFF_HEAD_DIM + DIFF_WIDTH
           + len(DIL_PATTERNS) * 3 * DIL_HEADS * DIL_HEAD_DIM
           + MLA_Q_LORA + MLA_KV_LORA + MLA_ROPE_DIM
           + N_BRANCHES * D_MODEL)

kernel_name = "hybrid_gated_diff_dilated_mla_encoder"


def _in_layout():
    segs = [("diff_q", DIFF_HEADS * 2 * DIFF_HEAD_DIM),
            ("diff_k", DIFF_HEADS * 2 * DIFF_HEAD_DIM),
            ("diff_v", DIFF_WIDTH)]
    for g in range(len(DIL_PATTERNS)):
        for t in ("q", "k", "v"):
            segs.append(("dil%d_%s" % (g, t), DIL_HEADS * DIL_HEAD_DIM))
    segs += [("mla_cq", MLA_Q_LORA), ("mla_ckv", MLA_KV_LORA), ("mla_kr", MLA_ROPE_DIM)]
    segs += [("gate%d" % i, D_MODEL) for i in range(N_BRANCHES)]
    layout, off = {}, 0
    for name, w in segs:
        layout[name] = (off, off + w)
        off += w
    return layout


def _rmsnorm(x, g):
    x32 = x.astype(jnp.float32)
    y = x32 * lax.rsqrt(jnp.mean(x32 * x32, axis=-1, keepdims=True) + NORM_EPS)
    return (y * g.astype(jnp.float32)).astype(x.dtype)


def _rope(x, pos):
    half = x.shape[-1] // 2
    inv = ROPE_THETA ** (-jnp.arange(half, dtype=jnp.float32) / half)
    ang = pos[:, None] * inv[None, :]
    cos = jnp.cos(ang)[None, :, None, :].astype(x.dtype)
    sin = jnp.sin(ang)[None, :, None, :].astype(x.dtype)
    x1, x2 = x[..., :half], x[..., half:]
    return jnp.concatenate([x1 * cos - x2 * sin, x2 * cos + x1 * sin], axis=-1)


def _to_qblocks(t):
    b, s = t.shape[:2]
    return t.reshape((b, s // Q_BLOCK, Q_BLOCK) + t.shape[2:]).swapaxes(0, 1)


def _from_qblocks(t):
    nb, b, qb = t.shape[:3]
    return t.swapaxes(0, 1).reshape((b, nb * qb) + t.shape[3:])


def _dense_attention(q, k, v, scale):
    def one(qb):
        s = jnp.einsum('bqhd,bkhd->bhqk', qb, k).astype(jnp.float32) * scale
        p = jax.nn.softmax(s, axis=-1).astype(v.dtype)
        return jnp.einsum('bhqk,bkhd->bqhd', p, v)
    return _from_qblocks(lax.map(one, _to_qblocks(q)))


def _differential_attention(q1, q2, k1, k2, v, lam):
    scale = DIFF_HEAD_DIM ** -0.5
    def one(qs):
        qb1, qb2 = qs
        p1 = jax.nn.softmax(jnp.einsum('bqhd,bkhd->bhqk', qb1, k1).astype(jnp.float32) * scale, axis=-1)
        p2 = jax.nn.softmax(jnp.einsum('bqhd,bkhd->bhqk', qb2, k2).astype(jnp.float32) * scale, axis=-1)
        a = (p1 - lam * p2).astype(v.dtype)
        return jnp.einsum('bhqk,bkhd->bqhd', a, v)
    return _from_qblocks(lax.map(one, (_to_qblocks(q1), _to_qblocks(q2))))


def _dilated_group(q, k, v, window, dilation):
    b, s_len, h, dh = q.shape
    span = window // (2 * dilation)
    blk = span
    n = -(-s_len // (dilation * blk)) * blk
    lp = n * dilation
    nb = n // blk
    pad = lp - s_len

    def blocks(t):
        t = jnp.pad(t, ((0, 0), (0, pad), (0, 0), (0, 0)))
        return t.reshape(b, nb, blk, dilation, h, dh)

    def windows(t):
        tp = jnp.pad(t, [(0, 0), (1, 1)] + [(0, 0)] * (t.ndim - 2))
        return jnp.concatenate([tp[:, :-2], tp[:, 1:-1], tp[:, 2:]], axis=2)

    qb = blocks(q)
    kw = windows(blocks(k))
    vw = windows(blocks(v))
    valid = (jnp.arange(lp) < s_len).reshape(1, nb, blk, dilation)
    valid_w = windows(valid)

    sc = jnp.einsum('bnqchd,bnkchd->bnchqk', qb, kw).astype(jnp.float32) * (dh ** -0.5)
    rel = jnp.arange(3 * blk)[None, :] - blk - jnp.arange(blk)[:, None]
    band = jnp.abs(rel) <= span
    mask = band[None, None, None, None] & valid_w.transpose(0, 1, 3, 2)[:, :, :, None, None, :]
    sc = jnp.where(mask, sc, NEG_INF)
    m = jnp.max(sc, axis=-1, keepdims=True)
    p = jnp.exp(sc - m)
    l = jnp.sum(p, axis=-1, keepdims=True)
    o = jnp.einsum('bnchqk,bnkchd->bnqchd', (p / l).astype(v.dtype), vw)
    lse = (m + jnp.log(l))[..., 0]
    o = o.reshape(b, lp, h, dh)[:, :s_len]
    lse = lse.transpose(0, 1, 4, 2, 3).reshape(b, lp, h)[:, :s_len]
    return o, lse


def _mixer(h, layer_idx, w_in, b_gate, diff_lambda, g_diff, g_cq, g_ckv, w_uq, w_ukv,
           w_o_diff, w_o_dil, w_o_mla, w_out):
    b, s_len, _ = h.shape
    pos = jnp.arange(s_len, dtype=jnp.float32)
    layout = _in_layout()

    def proj(name):
        a, e = layout[name]
        return h @ w_in[:, a:e]

    q = _rope(proj("diff_q").reshape(b, s_len, 2 * DIFF_HEADS, DIFF_HEAD_DIM), pos)
    k = _rope(proj("diff_k").reshape(b, s_len, 2 * DIFF_HEADS, DIFF_HEAD_DIM), pos)
    q = q.reshape(b, s_len, DIFF_HEADS, 2, DIFF_HEAD_DIM)
    k = k.reshape(b, s_len, DIFF_HEADS, 2, DIFF_HEAD_DIM)
    v = proj("diff_v").reshape(b, s_len, DIFF_HEADS, DIFF_V_DIM)
    lam_init = 0.8 - 0.6 * math.exp(-0.3 * layer_idx)
    lp32 = diff_lambda.astype(jnp.float32)
    lam = jnp.exp(jnp.sum(lp32[0] * lp32[1])) - jnp.exp(jnp.sum(lp32[2] * lp32[3])) + lam_init
    o_a = _differential_attention(q[..., 0, :], q[..., 1, :], k[..., 0, :], k[..., 1, :], v, lam)
    o_a = _rmsnorm(o_a, g_diff) * (1.0 - lam_init)
    y_a = o_a.reshape(b, s_len, DIFF_WIDTH) @ w_o_diff

    outs, lses = [], []
    for g, (window, dilation) in enumerate(DIL_PATTERNS):
        qg = _rope(proj("dil%d_q" % g).reshape(b, s_len, DIL_HEADS, DIL_HEAD_DIM), pos)
        kg = _rope(proj("dil%d_k" % g).reshape(b, s_len, DIL_HEADS, DIL_HEAD_DIM), pos)
        vg = proj("dil%d_v" % g).reshape(b, s_len, DIL_HEADS, DIL_HEAD_DIM)
        o_g, lse_g = _dilated_group(qg, kg, vg, window, dilation)
        outs.append(o_g)
        lses.append(lse_g)
    alpha = jax.nn.softmax(jnp.stack(lses, axis=0), axis=0)
    o_b = jnp.sum(alpha[..., None].astype(outs[0].dtype) * jnp.stack(outs, axis=0), axis=0)
    y_b = o_b.reshape(b, s_len, DIL_WIDTH) @ w_o_dil

    c_q = _rmsnorm(proj("mla_cq"), g_cq)
    c_kv = _rmsnorm(proj("mla_ckv"), g_ckv)
    k_rope = _rope(proj("mla_kr").reshape(b, s_len, 1, MLA_ROPE_DIM), pos)
    qh = (c_q @ w_uq).reshape(b, s_len, MLA_HEADS, MLA_NOPE_DIM + MLA_ROPE_DIM)
    q_c = jnp.concatenate([qh[..., :MLA_NOPE_DIM], _rope(qh[..., MLA_NOPE_DIM:], pos)], axis=-1)
    kv = (c_kv @ w_ukv).reshape(b, s_len, MLA_HEADS, MLA_NOPE_DIM + MLA_V_DIM)
    k_c = jnp.concatenate([kv[..., :MLA_NOPE_DIM],
                           jnp.broadcast_to(k_rope, (b, s_len, MLA_HEADS, MLA_ROPE_DIM))], axis=-1)
    v_c = kv[..., MLA_NOPE_DIM:]
    o_c = _dense_attention(q_c, k_c, v_c, (MLA_NOPE_DIM + MLA_ROPE_DIM) ** -0.5)
    y_c = o_c.reshape(b, s_len, MLA_WIDTH) @ w_o_mla

    merged = (jax.nn.sigmoid(proj("gate0") + b_gate[0]) * y_a
              + jax.nn.sigmoid(proj("gate1") + b_gate[1]) * y_b
              + jax.nn.sigmoid(proj("gate2") + b_gate[2]) * y_c)
    return merged @ w_out


def setup_inputs(seed: int = 0) -> dict:
    key = jax.random.key(seed)
    ks = jax.random.split(key, 20)

    def nrm(k, shape, fan_in):
        return jax.random.normal(k, shape, jnp.float32) * (fan_in ** -0.5)

    def gain(k, shape):
        return 1.0 + 0.05 * jax.random.normal(k, shape, jnp.float32)

    return {
        "x": jax.random.normal(ks[0], (BATCH, SEQ, D_MODEL), jnp.float32),
        "w_in": nrm(ks[1], (DEPTH, D_MODEL, IN_COLS), D_MODEL),
        "b_gate": 0.01 * jax.random.normal(ks[2], (DEPTH, N_BRANCHES, D_MODEL), jnp.float32),
        "g_mix": gain(ks[3], (DEPTH, D_MODEL)),
        "diff_lambda": 0.1 * jax.random.normal(ks[4], (DEPTH, 4, DIFF_HEAD_DIM), jnp.float32),
        "g_diff": gain(ks[5], (DEPTH, DIFF_V_DIM)),
        "g_cq": gain(ks[6], (DEPTH, MLA_Q_LORA)),
        "g_ckv": gain(ks[7], (DEPTH, MLA_KV_LORA)),
        "w_uq": nrm(ks[8], (DEPTH, MLA_Q_LORA, MLA_HEADS * (MLA_NOPE_DIM + MLA_ROPE_DIM)), MLA_Q_LORA),
        "w_ukv": nrm(ks[9], (DEPTH, MLA_KV_LORA, MLA_HEADS * (MLA_NOPE_DIM + MLA_V_DIM)), MLA_KV_LORA),
        "w_o_diff": nrm(ks[10], (DEPTH, DIFF_WIDTH, D_MODEL), DIFF_WIDTH),
        "w_o_dil": nrm(ks[11], (DEPTH, DIL_WIDTH, D_MODEL), DIL_WIDTH),
        "w_o_mla": nrm(ks[12], (DEPTH, MLA_WIDTH, D_MODEL), MLA_WIDTH),
        "w_out": nrm(ks[13], (DEPTH, D_MODEL, D_MODEL), D_MODEL),
        "g_mlp": gain(ks[14], (DEPTH, D_MODEL)),
        "w_up": nrm(ks[15], (DEPTH, D_MODEL, MLP_HIDDEN), D_MODEL),
        "w_down": nrm(ks[16], (DEPTH, MLP_HIDDEN, D_MODEL), MLP_HIDDEN),
        "g_final": gain(ks[17], (D_MODEL,)),
    }


def reference(x, w_in, b_gate, g_mix, diff_lambda, g_diff, g_cq, g_ckv, w_uq, w_ukv,
              w_o_diff, w_o_dil, w_o_mla, w_out, g_mlp, w_up, w_down, g_final):
    for l in range(DEPTH):
        h = _rmsnorm(x, g_mix[l])
        x = x + _mixer(h, l, w_in[l], b_gate[l], diff_lambda[l], g_diff[l], g_cq[l], g_ckv[l],
                       w_uq[l], w_ukv[l], w_o_diff[l], w_o_dil[l], w_o_mla[l], w_out[l])
        h = _rmsnorm(x, g_mlp[l])
        x = x + jnp.square(jax.nn.relu(h @ w_up[l])) @ w_down[l]
    return _rmsnorm(x, g_final)
```

```cpp
#include <hip/hip_runtime.h>
#include <hip/hip_cooperative_groups.h>
#include <cstdio>
#include <cstdint>
namespace cg = cooperative_groups;

#ifndef MK_MULTI
#define MK_MULTI 0
#endif

#define LAS __attribute__((address_space(3)))
typedef unsigned short bf16_t;
typedef short bf16x8 __attribute__((ext_vector_type(8)));
typedef short s16x4 __attribute__((ext_vector_type(4)));
typedef float f32x4 __attribute__((ext_vector_type(4)));
typedef float f32x16 __attribute__((ext_vector_type(16)));
typedef unsigned u32x4 __attribute__((ext_vector_type(4)));
typedef unsigned u32x2 __attribute__((ext_vector_type(2)));

constexpr int SEQ = 8192, DM = 1024, MTOT = 65536, MH = 32768, NHALF = 2, DEPTH = 2;
constexpr int NIN = 8192;
constexpr int INC = 7968;
constexpr int FF = 4096;
constexpr float EPS = 1e-6f;
constexpr int PC_DQ = 0, PC_DK = 512, PC_DV = 1024, PC_DIL = 1536, PC_CQ = 3840, PC_CKV = 4608, PC_KR = 4864, PC_GATE = 5120;

constexpr size_t MiB = 1u << 20;
constexpr size_t WS_SSQ_Q = 0, WS_SSQ_KV = 128 * 1024, WS_SSQ_X1 = 256 * 1024, WS_SSQ_X2 = 384 * 1024;
constexpr size_t WS_BAR = 512 * 1024;
constexpr size_t WS_COS64 = 1 * MiB, WS_SIN64 = 2 * MiB, WS_COS32 = 3 * MiB, WS_SIN32 = 3 * MiB + 512 * 1024;
constexpr size_t WS_W = 4 * MiB, W_LAYER = 40 * MiB;
constexpr size_t WO_IN = 0, WO_UQ = 16 * MiB, WO_UKV = 18 * MiB, WO_OD = 19 * MiB, WO_OL = 20 * MiB, WO_OM = 21 * MiB, WO_OUT = 22 * MiB, WO_UP = 24 * MiB, WO_DN = 32 * MiB;
constexpr size_t WS_H = 84 * MiB;
constexpr size_t WS_P = 148 * MiB;
constexpr size_t WS_QC = 660 * MiB;
constexpr size_t WS_KVC = 708 * MiB;
constexpr size_t WS_OD = 772 * MiB;
constexpr size_t WS_MB = 836 * MiB;
constexpr size_t WS_LSE = 900 * MiB;
constexpr size_t WS_END = 902 * MiB;

__device__ __forceinline__ unsigned cvt_pk_bf16(float lo, float hi) { unsigned r; asm volatile("v_cvt_pk_bf16_f32 %0, %1, %2" : "=v"(r) : "v"(lo), "v"(hi)); return r; }
__device__ __forceinline__ float bf_lo(unsigned u) { return __uint_as_float(u << 16); }
__device__ __forceinline__ float bf_hi(unsigned u) { return __uint_as_float(u & 0xffff0000u); }

namespace pg8 {
constexpr int BM = 256, BK = 64, HALF = 128, HTB = HALF * BK * 2, STAGE_BYTES = 8 * HTB, NXCD = 8, WGM = 4;
__host__ __device__ __forceinline__ int lds_byte(int r, int c) { const int st = (r >> 4) * 2 + (c >> 5), rr = r & 15, cc = c & 31, ob = rr * 64 + cc * 2; return st * 1024 + (ob ^ (((ob >> 9) & 1) << 5)); }
__host__ __device__ __forceinline__ void stage_rc(int b, int& R, int& C) { const int st = b / 1024, sb = b % 1024, swz = sb ^ (((sb >> 9) & 1) << 5); R = (st >> 1) * 16 + swz / 64; C = (st & 1) * 32 + (swz % 64) / 2; }
__host__ __device__ __forceinline__ int perm32(int rho) { const int n = rho >> 4, i = rho & 15; return 8 * (i >> 2) + 4 * n + (i & 3); }

struct Unit { int pm, pn; };
struct Gemm { const bf16_t* A; const bf16_t* Bt; };

struct StaticOrder {
    int nM, nN, nwg, G, c;
    __host__ __device__ void init(int M, int N, int G_, int c_) { nM = M / BM; nN = N / BM; nwg = nM * nN; G = G_; c = c_; }
    __host__ __device__ bool next(int i, Unit& u) const {
        const long L = (long)i * G + c; if (L >= nwg) return false;
        int wgid = (int)L; { const int q = nwg / NXCD, r = nwg % NXCD, xcd = wgid % NXCD, off = wgid / NXCD; wgid = (xcd < r ? xcd * (q + 1) : r * (q + 1) + (xcd - r) * q) + off; }
        const int nig = WGM * nN, gid = wgid / nig, fm = gid * WGM, gsz = (nM - fm) < WGM ? (nM - fm) : WGM;
        u.pm = fm + ((wgid % nig) % gsz); u.pn = (wgid % nig) / gsz; return true;
    }
};

template <class Epi, bool ALIGN_EPI, int M_, int N_, int K_, int LDA, int LDB>
__device__ __forceinline__ void gemm_phase(LAS unsigned char* lds, const int tid_in, const int G_in, const int bx_in, const Gemm g, const Epi& E) {
    int tid = tid_in; asm volatile("" : "+v"(tid));
    int Gl = G_in, bxl = bx_in; asm volatile("" : "+s"(Gl), "+s"(bxl));
    StaticOrder S; S.init(M_, N_, Gl, bxl);
    const int wid = __builtin_amdgcn_readfirstlane(tid >> 6), lane = tid & 63, wr = wid >> 2, wc = wid & 3, fr = lane & 15, fq = lane >> 4;
    constexpr int nt = K_ / BK;
    unsigned voffA[2], voffB[2];
#pragma unroll
    for (int i = 0; i < 2; ++i) { int R, C; stage_rc(tid * 16 + i * 8192, R, C); const int Rb = Epi::PERM ? ((R & ~31) + perm32(R & 31)) : R;
        voffA[i] = (unsigned)(R * LDA + C) * 2u; voffB[i] = (unsigned)(Rb * LDB + C) * 2u; }
    constexpr size_t kstep = (size_t)(BK * 2);
    constexpr size_t hstepA = (size_t)HALF * LDA * 2, hstepB = (size_t)HALF * LDB * 2;
    constexpr size_t tstepA = 2 * hstepA, tstepB = 2 * hstepB;
    const unsigned ldsw = (unsigned)wid * 1024u;
    const int aoff = lds_byte(wr * 64 + fr, fq * 8), boff = lds_byte(wc * 32 + fr, fq * 8);
#define PG8_SA(b, h) (((b) * 2 + (h)) * HTB)
#define PG8_SB(b, h) ((4 + (b) * 2 + (h)) * HTB)
#define PG8_STAGE(bufoff, gbase, voff) do { _Pragma("unroll") for (int _i = 0; _i < 2; ++_i) \
        __builtin_amdgcn_global_load_lds((const unsigned*)((const char*)(gbase) + (voff)[_i]), (LAS unsigned*)(lds + (bufoff) + ldsw + _i * 8192), 16, 0, 0); } while (0)
#define PG8_LDA(dst, b, h) do { _Pragma("unroll") for (int m = 0; m < 4; ++m) _Pragma("unroll") for (int k = 0; k < 2; ++k) dst[m][k] = *(const LAS bf16x8*)(lds + PG8_SA(b, h) + aoff + m * 2048 + k * 1024); } while (0)
#define PG8_LDB(dst, b, h) do { _Pragma("unroll") for (int n = 0; n < 2; ++n) _Pragma("unroll") for (int k = 0; k < 2; ++k) dst[n][k] = *(const LAS bf16x8*)(lds + PG8_SB(b, h) + boff + n * 2048 + k * 1024); } while (0)
#define PG8_MMA(ai, bj, At, Bt) do { __builtin_amdgcn_s_setprio(1); _Pragma("unroll") for (int m = 0; m < 4; ++m) _Pragma("unroll") for (int n = 0; n < 2; ++n) _Pragma("unroll") for (int k = 0; k < 2; ++k) \
        acc[ai][bj][m][n] = __builtin_amdgcn_mfma_f32_16x16x32_bf16(Bt[n][k], At[m][k], acc[ai][bj][m][n], 0, 0, 0); __builtin_amdgcn_s_setprio(0); } while (0)
#define PG8_WAIT_V(n) asm volatile("s_waitcnt vmcnt(" #n ")" ::: "memory")
#define PG8_WAIT_L(n) asm volatile("s_waitcnt lgkmcnt(" #n ")" ::: "memory")
#define PG8_BAR __builtin_amdgcn_s_barrier()
#define PG8_SCHED __builtin_amdgcn_sched_barrier(0)
    Unit cur, nxt; int ui = 0;
    if (!S.next(0, cur)) return;
    f32x4 acc[2][2][4][2];
#pragma unroll
    for (int a = 0; a < 2; ++a)
#pragma unroll
        for (int b = 0; b < 2; ++b)
#pragma unroll
            for (int m = 0; m < 4; ++m)
#pragma unroll
                for (int n = 0; n < 2; ++n) acc[a][b][m][n] = (f32x4){0.f, 0.f, 0.f, 0.f};
    bf16x8 At[4][2], B0[2][2], B1[2][2];
    const char* cA = (const char*)g.A + (size_t)cur.pm * tstepA; const char* cB = (const char*)g.Bt + (size_t)cur.pn * tstepB;
    PG8_STAGE(PG8_SB(0, 0), cB, voffB); PG8_STAGE(PG8_SB(0, 1), cB + hstepB, voffB); PG8_STAGE(PG8_SA(0, 0), cA, voffA); PG8_STAGE(PG8_SA(0, 1), cA + hstepA, voffA);
    if (wr == 1) PG8_BAR;
    PG8_WAIT_V(2); PG8_BAR;
    PG8_STAGE(PG8_SB(1, 0), cB + kstep, voffB); PG8_STAGE(PG8_SA(1, 0), cA + kstep, voffA); PG8_STAGE(PG8_SB(1, 1), cB + hstepB + kstep, voffB);
    PG8_WAIT_V(6); PG8_BAR;
    for (;;) {
        const bool has_next = S.next(ui + 1, nxt);
        const char* nA = has_next ? (const char*)g.A + (size_t)nxt.pm * tstepA : cA; const char* nB = has_next ? (const char*)g.Bt + (size_t)nxt.pn * tstepB : cB;
#pragma nounroll
        for (int t = 0; t < nt; t += 2) {
            const bool last = (t == nt - 2);
            const char* a1 = cA + (size_t)(t + 1) * kstep;
            const char* a2 = last ? nA : cA + (size_t)(t + 2) * kstep; const char* b2 = last ? nB : cB + (size_t)(t + 2) * kstep;
            const char* a3 = a2 + kstep; const char* b3 = b2 + kstep;
            PG8_LDB(B0, 0, 0); PG8_LDB(B1, 0, 1); PG8_SCHED; PG8_LDA(At, 0, 0); PG8_STAGE(PG8_SA(1, 1), a1 + hstepA, voffA);
            PG8_WAIT_V(8); PG8_WAIT_L(0); PG8_BAR; PG8_MMA(0, 0, At, B0); PG8_MMA(0, 1, At, B1); PG8_BAR; PG8_SCHED;
            PG8_LDA(At, 0, 1); PG8_STAGE(PG8_SB(0, 0), b2, voffB); PG8_STAGE(PG8_SB(0, 1), b2 + hstepB, voffB); PG8_STAGE(PG8_SA(0, 0), a2, voffA);
            PG8_WAIT_V(8); PG8_WAIT_L(0); PG8_BAR; PG8_MMA(1, 0, At, B0); PG8_MMA(1, 1, At, B1); PG8_BAR; PG8_SCHED;
            PG8_LDB(B0, 1, 0); PG8_LDB(B1, 1, 1); PG8_SCHED; PG8_LDA(At, 1, 0); PG8_STAGE(PG8_SA(0, 1), a2 + hstepA, voffA);
            PG8_WAIT_V(8); PG8_WAIT_L(0); PG8_BAR; PG8_MMA(0, 0, At, B0); PG8_MMA(0, 1, At, B1); PG8_BAR; PG8_SCHED;
            PG8_LDA(At, 1, 1); PG8_STAGE(PG8_SB(1, 0), b3, voffB); PG8_STAGE(PG8_SB(1, 1), b3 + hstepB, voffB); PG8_STAGE(PG8_SA(1, 0), a3, voffA);
            PG8_WAIT_V(8); PG8_WAIT_L(0); PG8_BAR; PG8_MMA(1, 0, At, B0); PG8_MMA(1, 1, At, B1); PG8_BAR; PG8_SCHED;
        }
        if constexpr (ALIGN_EPI) { if (wr == 0) PG8_BAR; }
        E(acc, cur, wr, wc, fr, fq);
        if (!has_next) break;
#pragma unroll
        for (int a = 0; a < 2; ++a)
#pragma unroll
            for (int b = 0; b < 2; ++b)
#pragma unroll
                for (int m = 0; m < 4; ++m)
#pragma unroll
                    for (int n = 0; n < 2; ++n) acc[a][b][m][n] = (f32x4){0.f, 0.f, 0.f, 0.f};
        cur = nxt; cA = nA; cB = nB; ++ui;
        if constexpr (ALIGN_EPI) { if (wr == 1) PG8_BAR; }
    }
    PG8_WAIT_V(0);
    if constexpr (!ALIGN_EPI) { if (wr == 0) PG8_BAR; }
    PG8_BAR;
#undef PG8_SA
#undef PG8_SB
#undef PG8_STAGE
#undef PG8_LDA
#undef PG8_LDB
#undef PG8_MMA
#undef PG8_WAIT_V
#undef PG8_WAIT_L
#undef PG8_BAR
#undef PG8_SCHED
}

__device__ __forceinline__ void store8(bf16_t* p, f32x4 v0, f32x4 v1) {
    u32x4 w; w.x = cvt_pk_bf16(v0[0], v0[1]); w.y = cvt_pk_bf16(v0[2], v0[3]); w.z = cvt_pk_bf16(v1[0], v1[1]); w.w = cvt_pk_bf16(v1[2], v1[3]); *(u32x4*)p = w;
}
struct EpiInProj {
    static constexpr bool PERM = true;
    bf16_t* P; const float* bgate; const float *cos64, *sin64, *cos32, *sin32; float *ssq_q, *ssq_kv; const float* ssq_x;
    __device__ __forceinline__ void operator()(const f32x4 (&acc)[2][2][4][2], const Unit& u, int wr, int wc, int fr, int fq) const {
        const int pn = u.pn; int type;
        if (pn < 4) type = 0; else if (pn < 6) type = 1; else if (pn < 15) type = ((pn - 6) % 3 < 2) ? 0 : 1; else if (pn < 18) type = 2; else if (pn == 18) type = 3; else if (pn == 19) type = 4; else type = 5;
        const int row0 = u.pm * BM + wr * 64 + fr, col0 = pn * BM + wc * 32 + 8 * fq;
        const float qs = (pn < 2 || (pn >= 6 && pn < 15 && (pn - 6) % 3 == 0)) ? 0.125f * 1.4426950408889634f : 1.f;
#pragma unroll
        for (int ai = 0; ai < 2; ++ai)
#pragma unroll
            for (int m = 0; m < 4; ++m) {
                const int row = row0 + ai * HALF + m * 16, pos = row & (SEQ - 1);
                bf16_t* rowp = P + (size_t)row * NIN + col0;
                const float rstd = rsqrtf(ssq_x[row] * (1.f / DM) + EPS);
                float ss = 0.f;
                f32x4 c4 = (f32x4){1.f, 1.f, 1.f, 1.f}, s4 = (f32x4){0.f, 0.f, 0.f, 0.f};
                if (type == 0) { const int a = 4 * (wc & 1) + fq; c4 = *(const f32x4*)(cos64 + pos * 32 + 4 * a); s4 = *(const f32x4*)(sin64 + pos * 32 + 4 * a); }
                else if (type == 4) { c4 = *(const f32x4*)(cos32 + pos * 16 + 4 * fq); s4 = *(const f32x4*)(sin32 + pos * 16 + 4 * fq); }
#pragma unroll
                for (int bj = 0; bj < 2; ++bj) {
                    f32x4 v0 = acc[ai][bj][m][0] * rstd, v1 = acc[ai][bj][m][1] * rstd;
                    if (type == 0 || type == 4) { const f32x4 lo = v0 * c4 - v1 * s4, hi_ = v1 * c4 + v0 * s4; v0 = lo * qs; v1 = hi_ * qs; }
                    else if (type == 2 || type == 3) { ss += (v0[0] * v0[0] + v0[1] * v0[1]) + (v0[2] * v0[2] + v0[3] * v0[3]) + (v1[0] * v1[0] + v1[1] * v1[1]) + (v1[2] * v1[2] + v1[3] * v1[3]); }
                    else if (type == 5) { const float* bp = bgate + (col0 + bj * HALF - PC_GATE); const f32x4 b0 = *(const f32x4*)bp, b1 = *(const f32x4*)(bp + 4);
#pragma unroll
                        for (int e = 0; e < 4; ++e) { v0[e] = __builtin_amdgcn_rcpf(1.f + __builtin_amdgcn_exp2f(-1.4426950408889634f * (v0[e] + b0[e]))); v1[e] = __builtin_amdgcn_rcpf(1.f + __builtin_amdgcn_exp2f(-1.4426950408889634f * (v1[e] + b1[e]))); } }
                    store8(rowp + bj * HALF, v0, v1);
                }
                if (type == 2 || type == 3) { ss += __shfl_xor(ss, 16); ss += __shfl_xor(ss, 32);
                    if (fq == 0) __hip_atomic_fetch_add((type == 2 ? ssq_q : ssq_kv) + row, ss, __ATOMIC_RELAXED, __HIP_MEMORY_SCOPE_AGENT); }
                asm volatile("" ::: "memory");
            }
    }
};
struct EpiUp {
    static constexpr bool PERM = true;
    bf16_t* O; int ldo; const float* ssq; float inv_n; int rope_tile; const float *cos32, *sin32; float oscale;
    __device__ __forceinline__ void operator()(const f32x4 (&acc)[2][2][4][2], const Unit& u, int wr, int wc, int fr, int fq) const {
        const int row0 = u.pm * BM + wr * 64 + fr, col0 = u.pn * BM + wc * 32 + 8 * fq; const bool rope = (u.pn == rope_tile);
#pragma unroll
        for (int ai = 0; ai < 2; ++ai)
#pragma unroll
            for (int m = 0; m < 4; ++m) {
                const int row = row0 + ai * HALF + m * 16, pos = row & (SEQ - 1);
                const float rstd = rsqrtf(ssq[row] * inv_n + EPS) * oscale;
                f32x4 c4 = (f32x4){1.f, 1.f, 1.f, 1.f}, s4 = (f32x4){0.f, 0.f, 0.f, 0.f};
                if (rope) { c4 = *(const f32x4*)(cos32 + pos * 16 + 4 * fq); s4 = *(const f32x4*)(sin32 + pos * 16 + 4 * fq); }
#pragma unroll
                for (int bj = 0; bj < 2; ++bj) {
                    f32x4 v0 = acc[ai][bj][m][0] * rstd, v1 = acc[ai][bj][m][1] * rstd;
                    if (rope) { const f32x4 lo = v0 * c4 - v1 * s4, hi_ = v1 * c4 + v0 * s4; v0 = lo; v1 = hi_; }
                    store8(O + (size_t)row * ldo + col0 + bj * HALF, v0, v1);
                }
                asm volatile("" ::: "memory");
            }
    }
};
template <bool FIRST> struct EpiMerge {
    static constexpr bool PERM = true;
    bf16_t* MBp; const bf16_t* G;
    __device__ __forceinline__ void operator()(const f32x4 (&acc)[2][2][4][2], const Unit& u, int wr, int wc, int fr, int fq) const {
        const int row0 = u.pm * BM + wr * 64 + fr, col0 = u.pn * BM + wc * 32 + 8 * fq;
#pragma unroll
        for (int ai = 0; ai < 2; ++ai)
#pragma unroll
            for (int m = 0; m < 4; ++m) {
                const int row = row0 + ai * HALF + m * 16;
#pragma unroll
                for (int bj = 0; bj < 2; ++bj) {
                    const u32x4 gw = *(const u32x4*)(G + (size_t)row * NIN + col0 + bj * HALF);
                    bf16_t* mp = MBp + (size_t)row * DM + col0 + bj * HALF;
                    f32x4 o0 = (f32x4){0.f, 0.f, 0.f, 0.f}, o1 = o0;
                    if (!FIRST) { const u32x4 ow = *(const u32x4*)mp; o0 = (f32x4){bf_lo(ow.x), bf_hi(ow.x), bf_lo(ow.y), bf_hi(ow.y)}; o1 = (f32x4){bf_lo(ow.z), bf_hi(ow.z), bf_lo(ow.w), bf_hi(ow.w)}; }
                    const f32x4 g0 = (f32x4){bf_lo(gw.x), bf_hi(gw.x), bf_lo(gw.y), bf_hi(gw.y)}, g1 = (f32x4){bf_lo(gw.z), bf_hi(gw.z), bf_lo(gw.w), bf_hi(gw.w)};
                    store8(mp, o0 + g0 * acc[ai][bj][m][0], o1 + g1 * acc[ai][bj][m][1]);
                }
                asm volatile("" ::: "memory");
            }
    }
};
template <bool STATS> struct EpiResid {
    static constexpr bool PERM = false;
    const float* src; float* dst; bf16_t* H; float* ssq;
    __device__ __forceinline__ void operator()(const f32x4 (&acc)[2][2][4][2], const Unit& u, int wr, int wc, int fr, int fq) const {
        const int row0 = u.pm * BM + wr * 64 + fr, col0 = u.pn * BM + wc * 32 + 4 * fq;
#pragma unroll
        for (int ai = 0; ai < 2; ++ai)
#pragma unroll
            for (int m = 0; m < 4; ++m) { const int row = row0 + ai * HALF + m * 16; const size_t off = (size_t)row * DM + col0; float ss = 0.f;
#pragma unroll
                for (int bj = 0; bj < 2; ++bj)
#pragma unroll
                    for (int n = 0; n < 2; ++n) { const f32x4 b = *(const f32x4*)(src + off + bj * HALF + n * 16); const f32x4 v = b + acc[ai][bj][m][n]; *(f32x4*)(dst + off + bj * HALF + n * 16) = v;
                        if constexpr (STATS) { u32x2 w; w.x = cvt_pk_bf16(v[0], v[1]); w.y = cvt_pk_bf16(v[2], v[3]); *(u32x2*)(H + off + bj * HALF + n * 16) = w;
                            ss += (v[0] * v[0] + v[1] * v[1]) + (v[2] * v[2] + v[3] * v[3]); } }
                if constexpr (STATS) { ss += __shfl_xor(ss, 16); ss += __shfl_xor(ss, 32); if (fq == 0) __hip_atomic_fetch_add(ssq + row, ss, __ATOMIC_RELAXED, __HIP_MEMORY_SCOPE_AGENT); }
                asm volatile("" ::: "memory"); }
    }
};
struct EpiSqRelu {
    static constexpr bool PERM = true;
    bf16_t* O; int ldo; const float* ssq;
    __device__ __forceinline__ void operator()(const f32x4 (&acc)[2][2][4][2], const Unit& u, int wr, int wc, int fr, int fq) const {
        const int row0 = u.pm * BM + wr * 64 + fr, col0 = u.pn * BM + wc * 32 + 8 * fq;
#pragma unroll
        for (int ai = 0; ai < 2; ++ai)
#pragma unroll
            for (int m = 0; m < 4; ++m) { const int row = row0 + ai * HALF + m * 16; bf16_t* rowp = O + (size_t)row * ldo + col0; const float rstd = rsqrtf(ssq[row] * (1.f / DM) + EPS);
#pragma unroll
                for (int bj = 0; bj < 2; ++bj) { f32x4 v0 = acc[ai][bj][m][0], v1 = acc[ai][bj][m][1];
#pragma unroll
                    for (int e = 0; e < 4; ++e) { const float a = fmaxf(v0[e], 0.f) * rstd, b = fmaxf(v1[e], 0.f) * rstd; v0[e] = a * a; v1[e] = b * b; }
                    store8(rowp + bj * HALF, v0, v1); } }
    }
};
}

namespace att {
constexpr int KB0 = 0, KBSZ = 12288, VB0 = 2 * KBSZ, VBSZ = 16384, WSF_OFF = VB0 + 2 * VBSZ;
constexpr float THR = 8.f;
__device__ __forceinline__ int crow(int r, int hi) { return (r & 3) + 8 * (r >> 2) + 4 * hi; }
typedef short v4i16_t __attribute__((ext_vector_type(4)));
typedef float f32x2 __attribute__((ext_vector_type(2)));
__device__ __forceinline__ s16x4 vtr(const LAS unsigned char* p) { return __builtin_bit_cast(s16x4, __builtin_amdgcn_ds_read_tr16_b64_v4i16((LAS v4i16_t*)p)); }
__device__ __forceinline__ float max3f(float a, float b, float c) { return __builtin_fmaxf(__builtin_fmaxf(a, b), c); }

template <int DQK, int DV, bool DIL, int dl, int SQ0, int SQ1, int SK0, int SK1, int SV, int SO>
__device__ __forceinline__ void attn_unit(const bf16_t* Q0, const bf16_t* Q1, const bf16_t* K0, const bf16_t* K1, const bf16_t* V, bf16_t* O, float* L,
                                          const int q0, const int kv_lo, const int nt, LAS unsigned char* lds, const int tid) {
    constexpr int ND0 = DQK / 16, NDB = DV / 32, nseq = SEQ / dl;
    constexpr bool FILLM = (DV == 128);
    constexpr bool NEGM = true;
    const int lane = tid & 63, r32 = lane & 31, hi = lane >> 5; const int wid = __builtin_amdgcn_readfirstlane(tid >> 6);
    LAS float* wsf = (LAS float*)(lds + WSF_OFF) + wid * 64;
    const int qrow = q0 + wid * 32 + r32;
    bf16x8 qf[ND0];
#pragma unroll
    for (int d0 = 0; d0 < 4; ++d0) qf[d0] = *(const bf16x8*)(Q0 + (size_t)qrow * (size_t)(SQ0 * dl) + d0 * 16 + hi * 8);
    if constexpr (DQK == 96) {
#pragma unroll
        for (int d0 = 4; d0 < 6; ++d0) qf[d0] = *(const bf16x8*)(Q1 + (size_t)qrow * (size_t)(SQ1 * dl) + (d0 - 4) * 16 + hi * 8);
    }
    f32x16 o[NDB];
#pragma unroll
    for (int i = 0; i < NDB; ++i) o[i] = (f32x16){0.f, 0.f, 0.f, 0.f, 0.f, 0.f, 0.f, 0.f, 0.f, 0.f, 0.f, 0.f, 0.f, 0.f, 0.f, 0.f};
    const f32x16 zero16 = (f32x16){0.f, 0.f, 0.f, 0.f, 0.f, 0.f, 0.f, 0.f, 0.f, 0.f, 0.f, 0.f, 0.f, 0.f, 0.f, 0.f};
    f32x16 negm = zero16;
    float mrow = 0.f; f32x2 lacc = (f32x2){0.f, 0.f};
    u32x4 sk0, sk1, sv0, sv1;
    sk1 = (u32x4){0u, 0u, 0u, 0u}; sv1 = sk1;
    const int vlane_off = ((lane >> 4) & 1) * 32 + (lane & 3) * 8 + (4 * hi + ((lane & 15) >> 2)) * 64;
#define ATT_LOADK(t) do { \
        int kr_ = kv_lo + (t) * 64 + lane; if constexpr (DIL) kr_ = kr_ < 0 ? 0 : (kr_ >= nseq ? nseq - 1 : kr_); \
        sk0 = *(const u32x4*)(K0 + (size_t)kr_ * (size_t)(SK0 * dl) + wid * 8); \
        if constexpr (DQK == 96) { if (wid < 4) sk1 = *(const u32x4*)(K1 + (size_t)kr_ * (size_t)(SK1 * dl) + wid * 8); } \
    } while (0)
#define ATT_LOADV(t) do { \
        int vr_ = kv_lo + (t) * 64 + 16 * (wid & 3) + (lane >> 2); if constexpr (DIL) vr_ = vr_ < 0 ? 0 : (vr_ >= nseq ? nseq - 1 : vr_); \
        sv0 = *(const u32x4*)(V + (size_t)vr_ * (size_t)(SV * dl) + (wid >> 2) * 32 + (lane & 3) * 8); \
        if constexpr (DV == 128) sv1 = *(const u32x4*)(V + (size_t)vr_ * (size_t)(SV * dl) + (2 + (wid >> 2)) * 32 + (lane & 3) * 8); \
    } while (0)
#define ATT_STOREK(b) do { LAS unsigned char* kb_ = lds + KB0 + (b) * KBSZ; \
        *(LAS u32x4*)(kb_ + wid * 1024 + lane * 16) = sk0; \
        if constexpr (DQK == 96) { if (wid < 4) *(LAS u32x4*)(kb_ + (8 + wid) * 1024 + lane * 16) = sk1; } \
    } while (0)
#define ATT_STOREV(b) do { LAS unsigned char* vb_ = lds + VB0 + (b) * VBSZ; \
        *(LAS u32x4*)(vb_ + wid * 1024 + lane * 16) = sv0; \
        if constexpr (DV == 128) *(LAS u32x4*)(vb_ + (8 + wid) * 1024 + lane * 16) = sv1; \
    } while (0)
#define ATT_NEED(t) (!DIL || ((64 * (t) < 32 * wid + 160) && (64 * (t) + 64 > 32 * wid)))
#define ATT_SB() __builtin_amdgcn_sched_barrier(0)
#define ATT_RESC(P0, P1, MX) do { if (__any(MX > (NEGM ? THR : mrow + THR))) { \
        const float mxr_ = __builtin_fmaxf(MX, __shfl_xor(MX, 32)); const float dlt_ = __builtin_fmaxf(NEGM ? mxr_ : mxr_ - mrow, 0.f); \
        mrow += dlt_; const float f_ = __builtin_amdgcn_exp2f(-dlt_); lacc = lacc * f_; \
        _Pragma("unroll") for (int r = 0; r < 16; ++r) { P0[r] -= dlt_; P1[r] -= dlt_; if constexpr (!FILLM) negm[r] = -mrow; } \
        __builtin_amdgcn_wave_barrier(); if (hi == 0) wsf[r32] = f_; __builtin_amdgcn_wave_barrier(); \
        _Pragma("unroll") for (int g4 = 0; g4 < 4; ++g4) { const f32x4 fv = *(const LAS f32x4*)(wsf + 8 * g4 + 4 * hi); \
            _Pragma("unroll") for (int i = 0; i < NDB; ++i) { o[i][4 * g4 + 0] *= fv[0]; o[i][4 * g4 + 1] *= fv[1]; o[i][4 * g4 + 2] *= fv[2]; o[i][4 * g4 + 3] *= fv[3]; } } \
        __builtin_amdgcn_wave_barrier(); } } while (0)
#define ATT_EXPP(P0, P1, e) do { \
        f32x2 a_ = (f32x2){P0[2 * (e)], P0[2 * (e) + 1]}, b_ = (f32x2){P1[2 * (e)], P1[2 * (e) + 1]}; \
        a_[0] = __builtin_amdgcn_exp2f(a_[0]); a_[1] = __builtin_amdgcn_exp2f(a_[1]); b_[0] = __builtin_amdgcn_exp2f(b_[0]); b_[1] = __builtin_amdgcn_exp2f(b_[1]); \
        lacc = lacc + a_; lacc = lacc + b_; \
        pw[(e) >> 2][(e) & 3] = cvt_pk_bf16(a_[0], a_[1]); pw[2 + ((e) >> 2)][(e) & 3] = cvt_pk_bf16(b_[0], b_[1]); } while (0)
#define ATT_KRD(dst0, dst1, kb, d0) do { dst0 = *(const LAS bf16x8*)((kb) + (d0) * 2048); dst1 = *(const LAS bf16x8*)((kb) + (d0) * 2048 + 512); } while (0)
#define ATT_VRD(i, vb) do { vlo[(i) % 3] = vtr((vb) + ((i) % NDB) * 4096 + ((i) / NDB) * 1024); vhi[(i) % 3] = vtr((vb) + ((i) % NDB) * 4096 + ((i) / NDB) * 1024 + 512); } while (0)
#define ATT_STEP(PC0, PC1, MXC, PN0, PN1, MXN, t, HASQK) do { \
        constexpr bool sm_ = true; constexpr bool qk_ = (HASQK); \
        ATT_RESC(PC0, PC1, MXC); \
        if ((t) + 2 < nt) ATT_STOREK((t) & 1); \
        if ((t) + 1 < nt) ATT_STOREV(((t) + 1) & 1); \
        if ((t) + 3 < nt) ATT_LOADK((t) + 3); \
        if ((t) + 2 < nt) ATT_LOADV((t) + 2); \
        const bool zm_ = FILLM ? (bool)__all(mrow == 0.f) : true; (void)zm_; \
        { const LAS unsigned char* kb = lds + KB0 + (((t) + 1) & 1) * KBSZ + hi * 1024 + r32 * 16; \
          bf16x8 kc0, kc1, kn0, kn1; kn0 = kc0 = qf[0]; kn1 = kc1 = qf[0]; \
          if (qk_) ATT_KRD(kc0, kc1, kb, 0); \
          ATT_SB(); \
          _Pragma("unroll") for (int d0 = 0; d0 < ND0; ++d0) { \
              if (qk_ && d0 + 1 < ND0) ATT_KRD(kn0, kn1, kb, d0 + 1); \
              if (qk_) { if constexpr (FILLM) { if (d0 == 0) { if (zm_) { PN0 = __builtin_amdgcn_mfma_f32_32x32x16_bf16(kc0, qf[0], zero16, 0, 0, 0); } \
                                                                else { _Pragma("unroll") for (int r = 0; r < 16; ++r) { PN0[r] = -mrow; PN1[r] = -mrow; } PN0 = __builtin_amdgcn_mfma_f32_32x32x16_bf16(kc0, qf[0], PN0, 0, 0, 0); } } \
                                                 else PN0 = __builtin_amdgcn_mfma_f32_32x32x16_bf16(kc0, qf[d0], PN0, 0, 0, 0); } \
                         else PN0 = __builtin_amdgcn_mfma_f32_32x32x16_bf16(kc0, qf[d0], d0 == 0 ? negm : PN0, 0, 0, 0); } \
              if (sm_ && 2 * d0 < 8) ATT_EXPP(PC0, PC1, 2 * d0); \
              ATT_SB(); \
              if (qk_) { if constexpr (FILLM) { if (d0 == 0) { if (zm_) { PN1 = __builtin_amdgcn_mfma_f32_32x32x16_bf16(kc1, qf[0], zero16, 0, 0, 0); } \
                                                                else { PN1 = __builtin_amdgcn_mfma_f32_32x32x16_bf16(kc1, qf[0], PN1, 0, 0, 0); } } \
                                                 else PN1 = __builtin_amdgcn_mfma_f32_32x32x16_bf16(kc1, qf[d0], PN1, 0, 0, 0); } \
                         else PN1 = __builtin_amdgcn_mfma_f32_32x32x16_bf16(kc1, qf[d0], d0 == 0 ? negm : PN1, 0, 0, 0); } \
              if (sm_ && 2 * d0 + 1 < 8) ATT_EXPP(PC0, PC1, 2 * d0 + 1); \
              ATT_SB(); \
              kc0 = kn0; kc1 = kn1; } \
        } \
        { const LAS unsigned char* vb = lds + VB0 + ((t) & 1) * VBSZ + vlane_off; \
          s16x4 vlo[3], vhi[3]; float ma_ = -1e30f, mb_ = -1e30f; \
          if (sm_) { ATT_VRD(0, vb); ATT_VRD(1, vb); } \
          __builtin_amdgcn_s_setprio(1);        \
          ATT_SB(); \
          _Pragma("unroll") for (int i = 0; i < 4 * NDB; ++i) { \
              if (sm_ && i + 2 < 4 * NDB) ATT_VRD(i + 2, vb); \
              if (sm_) { const bf16x8 vf_ = (bf16x8){vlo[i % 3][0], vlo[i % 3][1], vlo[i % 3][2], vlo[i % 3][3], vhi[i % 3][0], vhi[i % 3][1], vhi[i % 3][2], vhi[i % 3][3]}; \
                  o[i % NDB] = __builtin_amdgcn_mfma_f32_32x32x16_bf16(__builtin_bit_cast(bf16x8, pw[i / NDB]), vf_, o[i % NDB], 0, 0, 0); } \
              if (qk_ && i < 8) { ma_ = max3f(ma_, PN0[2 * i], PN0[2 * i + 1]); mb_ = max3f(mb_, PN1[2 * i], PN1[2 * i + 1]); } \
              ATT_SB(); } \
          __builtin_amdgcn_s_setprio(0); \
          MXN = __builtin_fmaxf(ma_, mb_); } \
        __syncthreads(); } while (0)
#define ATT_STEP_DIL(PC0, PC1, MXC, PN0, PN1, MXN, t, HASQK) do { \
        const bool sm_ = ATT_NEED(t), qk_ = (HASQK) && ATT_NEED((t) + 1); \
        if (sm_) ATT_RESC(PC0, PC1, MXC); \
        if ((t) + 2 < nt) ATT_STOREK((t) & 1); \
        if ((t) + 1 < nt) ATT_STOREV(((t) + 1) & 1); \
        if ((t) + 3 < nt) ATT_LOADK((t) + 3); \
        if ((t) + 2 < nt) ATT_LOADV((t) + 2); \
        MXN = -1e30f; \
        if (qk_) { const LAS unsigned char* kb = lds + KB0 + (((t) + 1) & 1) * KBSZ + hi * 1024 + r32 * 16; \
            _Pragma("unroll") for (int d0 = 0; d0 < ND0; ++d0) { bf16x8 k0_, k1_; ATT_KRD(k0_, k1_, kb, d0); \
                PN0 = __builtin_amdgcn_mfma_f32_32x32x16_bf16(k0_, qf[d0], d0 == 0 ? (NEGM ? negm : zero16) : PN0, 0, 0, 0); \
                PN1 = __builtin_amdgcn_mfma_f32_32x32x16_bf16(k1_, qf[d0], d0 == 0 ? (NEGM ? negm : zero16) : PN1, 0, 0, 0); } \
            const int kvb_ = kv_lo + ((t) + 1) * 64; float a_ = -1e30f, b_ = -1e30f; \
            _Pragma("unroll") for (int r = 0; r < 16; ++r) { const int k0p = kvb_ + crow(r, hi), k1p = k0p + 32; const int e0_ = k0p - qrow, e1_ = k1p - qrow; \
                if (!((k0p >= 0) && (k0p < nseq) && (e0_ <= 64) && (e0_ >= -64))) PN0[r] = -1e30f; \
                if (!((k1p >= 0) && (k1p < nseq) && (e1_ <= 64) && (e1_ >= -64))) PN1[r] = -1e30f; \
                a_ = __builtin_fmaxf(a_, PN0[r]); b_ = __builtin_fmaxf(b_, PN1[r]); } \
            MXN = __builtin_fmaxf(a_, b_); } \
        if (sm_) { \
            _Pragma("unroll") for (int e = 0; e < 8; ++e) ATT_EXPP(PC0, PC1, e); \
            const LAS unsigned char* vb = lds + VB0 + ((t) & 1) * VBSZ + vlane_off; \
            _Pragma("unroll") for (int i = 0; i < 4 * NDB; ++i) { \
                const s16x4 lo_ = vtr(vb + (i % NDB) * 4096 + (i / NDB) * 1024), hh_ = vtr(vb + (i % NDB) * 4096 + (i / NDB) * 1024 + 512); \
                const bf16x8 vf_ = (bf16x8){lo_[0], lo_[1], lo_[2], lo_[3], hh_[0], hh_[1], hh_[2], hh_[3]}; \
                o[i % NDB] = __builtin_amdgcn_mfma_f32_32x32x16_bf16(__builtin_bit_cast(bf16x8, pw[i / NDB]), vf_, o[i % NDB], 0, 0, 0); } } \
        __syncthreads(); } while (0)
    f32x16 pa0, pa1, pb0, pb1; float mxa = -1e30f, mxb = -1e30f; u32x4 pw[4];
    pa0 = zero16; pa1 = zero16; pb0 = zero16; pb1 = zero16;
#pragma unroll
    for (int i = 0; i < 4; ++i) pw[i] = (u32x4){0u, 0u, 0u, 0u};
    ATT_LOADK(0); ATT_STOREK(0); ATT_LOADK(1); ATT_LOADV(0);
    __syncthreads();
    ATT_STOREK(1); ATT_STOREV(0); ATT_LOADK(2); ATT_LOADV(1);
    if (ATT_NEED(0)) { const LAS unsigned char* kb = lds + KB0 + hi * 1024 + r32 * 16;
#pragma unroll
        for (int d0 = 0; d0 < ND0; ++d0) { bf16x8 k0_, k1_; ATT_KRD(k0_, k1_, kb, d0);
            pa0 = __builtin_amdgcn_mfma_f32_32x32x16_bf16(k0_, qf[d0], d0 == 0 ? zero16 : pa0, 0, 0, 0);
            pa1 = __builtin_amdgcn_mfma_f32_32x32x16_bf16(k1_, qf[d0], d0 == 0 ? zero16 : pa1, 0, 0, 0); }
        if constexpr (DIL) { const int kvb_ = kv_lo;
#pragma unroll
            for (int r = 0; r < 16; ++r) { const int k0p = kvb_ + crow(r, hi), k1p = k0p + 32; const int e0_ = k0p - qrow, e1_ = k1p - qrow;
                if (!((k0p >= 0) && (k0p < nseq) && (e0_ <= 64) && (e0_ >= -64))) pa0[r] = -1e30f;
                if (!((k1p >= 0) && (k1p < nseq) && (e1_ <= 64) && (e1_ >= -64))) pa1[r] = -1e30f; } }
        float a_ = -1e30f, b_ = -1e30f;
#pragma unroll
        for (int i = 0; i < 8; ++i) { a_ = max3f(a_, pa0[2 * i], pa0[2 * i + 1]); b_ = max3f(b_, pa1[2 * i], pa1[2 * i + 1]); }
        mxa = __builtin_fmaxf(a_, b_);
    }
    __syncthreads();
    if constexpr (DIL) {
        for (int t = 0; t < nt; t += 2) {
            ATT_STEP_DIL(pa0, pa1, mxa, pb0, pb1, mxb, t, true);
            ATT_STEP_DIL(pb0, pb1, mxb, pa0, pa1, mxa, t + 1, (t + 2 < nt));
        }
    } else {
        for (int t = 0; t + 2 < nt; t += 2) {
            ATT_STEP(pa0, pa1, mxa, pb0, pb1, mxb, t, true);
            ATT_STEP(pb0, pb1, mxb, pa0, pa1, mxa, t + 1, true);
        }
        ATT_STEP(pa0, pa1, mxa, pb0, pb1, mxb, nt - 2, true);
        ATT_STEP(pb0, pb1, mxb, pa0, pa1, mxa, nt - 1, false);
    }
#undef ATT_STEP_DIL
#undef ATT_LOADK
#undef ATT_LOADV
#undef ATT_STOREK
#undef ATT_STOREV
#undef ATT_NEED
#undef ATT_SB
#undef ATT_RESC
#undef ATT_EXPP
#undef ATT_KRD
#undef ATT_VRD
#undef ATT_STEP
    const float lsum = lacc[0] + lacc[1];
    const float ltot = lsum + __shfl_xor(lsum, 32);
    __builtin_amdgcn_wave_barrier();
    if (hi == 0) wsf[r32] = 1.f / ltot;
    __builtin_amdgcn_wave_barrier();
    bf16_t* Ow = O + (size_t)(q0 + wid * 32) * (size_t)(SO * dl);
#pragma unroll
    for (int g4 = 0; g4 < 4; ++g4) { const f32x4 fv = *(const LAS f32x4*)(wsf + 8 * g4 + 4 * hi);
#pragma unroll
        for (int i = 0; i < 4; ++i) { const int r = 4 * g4 + i, orow = crow(r, hi);
#pragma unroll
            for (int db = 0; db < NDB; ++db) { const float v = o[db][r] * fv[i]; Ow[(size_t)orow * (size_t)(SO * dl) + db * 32 + r32] = (bf16_t)(cvt_pk_bf16(v, v) & 0xffffu); } } }
    if constexpr (DIL) { if (hi == 0) L[(size_t)qrow * (size_t)(4 * dl)] = (mrow + __log2f(ltot)) * 0.6931471805599453f; }
    __builtin_amdgcn_wave_barrier();
}
}

constexpr int NWAVES = 8, NTHREADS = 512;
constexpr int LDS_BYTES = 147456;
constexpr int XB_LDS_OFF = LDS_BYTES - 64;
struct Args { const float* in[18]; float* out; unsigned char* ws; int lo, hi; };

__device__ __forceinline__ float wave_sum(float v) {
#pragma unroll
    for (int o = 1; o < 64; o <<= 1) v += __shfl_xor(v, o);
    return v;
}
__device__ __forceinline__ unsigned f2bf(float f) { unsigned u = __builtin_bit_cast(unsigned, f); return (u + 0x7fffu + ((u >> 16) & 1u)) >> 16; }
__device__ __forceinline__ unsigned pk2(float lo, float hi) { return f2bf(lo) | (f2bf(hi) << 16); }

__device__ __forceinline__ int perm64(int p) { const int a = p >> 3, e = p & 7; return e < 4 ? 4 * a + e : 32 + 4 * a + (e - 4); }
__device__ __forceinline__ int perm32r(int p) { const int a = p >> 3, e = p & 7; return e < 4 ? 4 * a + e : 16 + 4 * a + (e - 4); }
__device__ __forceinline__ int inmap(int n) {
    if (n < 1024) return (n & ~63) + perm64(n & 63);
    if (n < 1536) return n;
    if (n < 3840) { const int r = n - 1536, g = r / 768, w = r % 768; if (w < 512) return 1536 + g * 768 + (w & ~63) + perm64(w & 63); return n; }
    if (n < 4864) return n;
    if (n < 4896) return 4864 + perm32r(n - 4864);
    if (n < 5120) return -1;
    return n - 5120 + 4896;
}
__device__ __forceinline__ int uqmap(int n) { if (n < 512) { return (n >> 6) * 96 + (n & 63); } const int r = n - 512; return (r >> 5) * 96 + 64 + perm32r(r & 31); }

__device__ __forceinline__ void prep_weight(const float* W, int K, int ldw, bf16_t* WT, int ndst, int kind, const float* sc, LAS float* scr, int gw, int NGW, int lane) {
    const int nblk = ndst / 32, nitems = (K / 64) * nblk;
    for (int item = gw; item < nitems; item += NGW) {
        const int kb = item / nblk, nb = item % nblk, k0 = 64 * kb, n0 = 32 * nb;
        const int nd = n0 + (lane & 31); const int src = kind == 0 ? nd : (kind == 1 ? inmap(nd) : uqmap(nd));
        float wv[32];
#pragma unroll
        for (int i = 0; i < 32; ++i) { const int kk = 2 * i + (lane >> 5); wv[i] = (src >= 0) ? W[(size_t)(k0 + kk) * ldw + src] : 0.f; }
#pragma unroll
        for (int i = 0; i < 32; ++i) { const int kk = 2 * i + (lane >> 5); float v = wv[i]; if (sc) v *= sc[k0 + kk]; scr[kk * 33 + (lane & 31)] = v; }
        asm volatile("s_waitcnt lgkmcnt(0)" ::: "memory"); __builtin_amdgcn_wave_barrier();
        const int c = lane & 7;
#pragma unroll
        for (int j = 0; j < 4; ++j) { const int n = (lane >> 3) + 8 * j; const LAS float* s = scr + (8 * c) * 33 + n;
            u32x4 o; o.x = pk2(s[0 * 33], s[1 * 33]); o.y = pk2(s[2 * 33], s[3 * 33]); o.z = pk2(s[4 * 33], s[5 * 33]); o.w = pk2(s[6 * 33], s[7 * 33]);
            *(u32x4*)(WT + (size_t)(n0 + n) * K + k0 + 8 * c) = o; }
        asm volatile("s_waitcnt lgkmcnt(0)" ::: "memory"); __builtin_amdgcn_wave_barrier();
    }
}

__device__ __forceinline__ void rows_to_bf16(const float* x, bf16_t* h, float* ssq, int gw, int NGW, int lane) {
    for (int m = gw; m < MH; m += NGW) {
        const f32x4* xr = (const f32x4*)(x + (size_t)m * DM) + lane;
        f32x4 v[4]; float s = 0.f;
#pragma unroll
        for (int j = 0; j < 4; ++j) { v[j] = xr[64 * j]; s += (v[j][0] * v[j][0] + v[j][1] * v[j][1]) + (v[j][2] * v[j][2] + v[j][3] * v[j][3]); }
        s = wave_sum(s);
        if (lane == 0) ssq[m] = s;
        u32x2* o8 = (u32x2*)(h + (size_t)m * DM) + lane;
#pragma unroll
        for (int j = 0; j < 4; ++j) { u32x2 w; w.x = pk2(v[j][0], v[j][1]); w.y = pk2(v[j][2], v[j][3]); o8[64 * j] = w; }
    }
}
__device__ __forceinline__ void zero_f32(float* p, int n, int gt, int NT_) { for (int i = gt; i < n; i += NT_) p[i] = 0.f; }

#define RLX_AGENT __ATOMIC_RELAXED, __HIP_MEMORY_SCOPE_AGENT
#define XB_TMO      128
#define XB_XCNT(j)  (256  + 64 * (j))
#define XB_XSUB(j)  (1280 + 64 * (j))
#define XB_XGEN(j)  (2304 + 64 * (j))
#define XB_TOP      3328
#define XB_TOPGEN   3392
#define XCD_BAR_WORDS 3456
#define XB_SPIN_CAP (1u << 18)

__device__ __forceinline__ unsigned xb_ld(unsigned* p)              { return __hip_atomic_load(p, __ATOMIC_RELAXED, __HIP_MEMORY_SCOPE_AGENT); }
__device__ __forceinline__ unsigned xb_add(unsigned* p, unsigned v) { return __hip_atomic_fetch_add(p, v, __ATOMIC_RELAXED, __HIP_MEMORY_SCOPE_AGENT); }
__device__ __forceinline__ unsigned xb_xcc_id() { return (unsigned)__builtin_amdgcn_s_getreg((3 << 11) | 20) & 0xFu; }
#define XB_SPIN(cond, bar) do { unsigned _sp = 0; while (cond) { __builtin_amdgcn_s_sleep(1); \
    if ((++_sp & 255u) == 0u) { if (xb_ld(&(bar)[XB_TMO])) break; if (_sp > XB_SPIN_CAP) { atomicAdd(&(bar)[XB_TMO], 1u); break; } } } } while (0)

struct XcdBarrier {
    unsigned* bar; unsigned x;
    volatile LAS unsigned* st;
};

__device__ __forceinline__ XcdBarrier xcd_barrier_post(unsigned* bar, volatile LAS unsigned* st) {
    XcdBarrier b; b.bar = bar; b.x = xb_xcc_id(); b.st = st;
    if (threadIdx.x == 0) (void)xb_add(&bar[XB_XCNT(b.x)], 1u);
    return b;
}
__device__ __forceinline__ void xcd_barrier_complete(unsigned* bar, unsigned x, unsigned& nloc, unsigned& nx) {
    const unsigned G = gridDim.x * gridDim.y * gridDim.z;
    unsigned sum, cnt, mine, sp = 0u;
    for (;;) {
        sum = 0u; cnt = 0u; mine = 0u;
#pragma unroll
        for (unsigned j = 0; j < 16; ++j) { const unsigned c = xb_ld(&bar[XB_XCNT(j)]); sum += c; cnt += (c > 0u) ? 1u : 0u; mine = (j == x) ? c : mine; }
        if (sum == G) break;
        __builtin_amdgcn_s_sleep(1);
        if ((++sp & 255u) == 0u) { if (xb_ld(&bar[XB_TMO])) break; if (sp > XB_SPIN_CAP) { atomicAdd(&bar[XB_TMO], 1u); break; } }
    }
    nloc = mine > 0u ? mine : 1u; nx = cnt > 0u ? cnt : 1u;
}

__device__ __forceinline__ void xcd_barrier(const XcdBarrier& b) {
    asm volatile("s_waitcnt vmcnt(0)" ::: "memory");
    __syncthreads();
    if (threadIdx.x == 0) {
        unsigned* bar = b.bar;
        __builtin_amdgcn_s_waitcnt(0);
        unsigned nloc = b.st[0], nx = b.st[1];
        if (nloc == 0u) { xcd_barrier_complete(bar, b.x, nloc, nx); b.st[0] = nloc; b.st[1] = nx; }
        const unsigned old = xb_add(&bar[XB_XSUB(b.x)], 1u);
        const unsigned gen = old / nloc;
        if (old + 1u == (gen + 1u) * nloc) {
            __builtin_amdgcn_fence(__ATOMIC_RELEASE, "agent");
            asm volatile("s_waitcnt vmcnt(0)" ::: "memory");
            const unsigned og = xb_add(&bar[XB_TOP], 1u);
            const unsigned tg = og / nx;
            if (og + 1u == (tg + 1u) * nx) xb_add(&bar[XB_TOPGEN], 1u);
            else XB_SPIN(xb_ld(&bar[XB_TOPGEN]) == tg, bar);
            __builtin_amdgcn_fence(__ATOMIC_ACQUIRE, "agent");
            xb_add(&bar[XB_XGEN(b.x)], 1u);
            asm volatile("s_waitcnt vmcnt(0)" ::: "memory");
        } else {
            XB_SPIN(xb_ld(&bar[XB_XGEN(b.x)]) == gen, bar);
            __builtin_amdgcn_fence(__ATOMIC_ACQUIRE, "agent");
            asm volatile("s_waitcnt vmcnt(0)" ::: "memory");
        }
    }
    __syncthreads();
}


constexpr int ST_PREP = 0, ST_PER = 10, NSTEPS = 1 + NHALF * DEPTH * ST_PER + 1;
#define WSP(T, off) ((T*)(ap->ws + (off)))
typedef const Args __attribute__((address_space(4))) * ArgsP;

__global__ void __launch_bounds__(NTHREADS, 2) mk_fwd(Args args) {
    extern __shared__ __attribute__((aligned(16))) unsigned char lds_raw[];
    LAS unsigned char* lds = (LAS unsigned char*)lds_raw;
    cg::grid_group grid = cg::this_grid();

    const int step_lo = args.lo, step_hi = args.hi;
    if (threadIdx.x < 2) ((volatile LAS unsigned*)(lds + XB_LDS_OFF))[threadIdx.x] = 0u;
    __syncthreads();
    if (step_hi - step_lo > 1) (void)xcd_barrier_post((unsigned*)(args.ws + WS_BAR), (volatile LAS unsigned*)(lds + XB_LDS_OFF));
    const int wave0 = __builtin_amdgcn_readfirstlane((int)threadIdx.x >> 6);
    for (int step = step_lo; step < step_hi; ++step) {
        ArgsP ap = (ArgsP)__builtin_amdgcn_kernarg_segment_ptr(); asm volatile("" : "+s"(ap));
        int wv_ = wave0; asm volatile("" : "+s"(wv_));
        int tid = wv_ * 64 + (int)__builtin_amdgcn_mbcnt_hi(~0u, __builtin_amdgcn_mbcnt_lo(~0u, 0u)); asm volatile("" : "+v"(tid));
        const int lane = tid & 63, wave = __builtin_amdgcn_readfirstlane(tid >> 6);
        int G = gridDim.x, bx = blockIdx.x; asm volatile("" : "+s"(G), "+s"(bx));
        const int vcu = (G % 8 == 0) ? (bx % 8) * (G / 8) + bx / 8 : bx;
        const int gw = vcu * NWAVES + wave, NGW = G * NWAVES;
        if (step == ST_PREP) {
            LAS float* scr = (LAS float*)(lds + wave * 16384);
            for (int l = 0; l < DEPTH; ++l) {
                unsigned char* wl = ap->ws + WS_W + (size_t)l * W_LAYER;
                prep_weight(ap->in[1] + (size_t)l * DM * INC, DM, INC, (bf16_t*)(wl + WO_IN), NIN, 1, ap->in[3] + l * DM, scr, gw, NGW, lane);
                prep_weight(ap->in[8] + (size_t)l * 768 * 768, 768, 768, (bf16_t*)(wl + WO_UQ), 768, 2, ap->in[6] + l * 768, scr, gw, NGW, lane);
                prep_weight(ap->in[9] + (size_t)l * 256 * 1024, 256, 1024, (bf16_t*)(wl + WO_UKV), 1024, 0, ap->in[7] + l * 256, scr, gw, NGW, lane);
                prep_weight(ap->in[10] + (size_t)l * 512 * DM, 512, DM, (bf16_t*)(wl + WO_OD), DM, 0, nullptr, scr, gw, NGW, lane);
                prep_weight(ap->in[11] + (size_t)l * 256 * DM, 256, DM, (bf16_t*)(wl + WO_OL), DM, 0, nullptr, scr, gw, NGW, lane);
                prep_weight(ap->in[12] + (size_t)l * 512 * DM, 512, DM, (bf16_t*)(wl + WO_OM), DM, 0, nullptr, scr, gw, NGW, lane);
                prep_weight(ap->in[13] + (size_t)l * DM * DM, DM, DM, (bf16_t*)(wl + WO_OUT), DM, 0, nullptr, scr, gw, NGW, lane);
                prep_weight(ap->in[15] + (size_t)l * DM * FF, DM, FF, (bf16_t*)(wl + WO_UP), FF, 0, ap->in[14] + l * DM, scr, gw, NGW, lane);
                prep_weight(ap->in[16] + (size_t)l * FF * DM, FF, DM, (bf16_t*)(wl + WO_DN), DM, 0, nullptr, scr, gw, NGW, lane);
            }
            const int gt = bx * NTHREADS + tid, NT_ = G * NTHREADS;
            float* cos64 = WSP(float, WS_COS64); float* sin64 = WSP(float, WS_SIN64); float* cos32 = WSP(float, WS_COS32); float* sin32 = WSP(float, WS_SIN32);
            for (int i = gt; i < SEQ * 32; i += NT_) { const int pos = i >> 5, j = i & 31;
                const float inv = powf(10000.f, -(float)j / 32.f); const float ang = (float)pos * inv;
                const double a = (double)ang; const double k = rint(a * 0.15915494309189535); const float r = (float)(a - k * 6.283185307179586);
                cos64[i] = cosf(r); sin64[i] = sinf(r); }
            for (int i = gt; i < SEQ * 16; i += NT_) { const int pos = i >> 4, j = i & 15;
                const float inv = powf(10000.f, -(float)j / 16.f); const float ang = (float)pos * inv;
                const double a = (double)ang; const double k = rint(a * 0.15915494309189535); const float r = (float)(a - k * 6.283185307179586);
                cos32[i] = cosf(r); sin32[i] = sinf(r); }
        } else if (step == NSTEPS - 1) {
            const float* gf = ap->in[17]; float* out = ap->out;
            for (int m = gw; m < MTOT; m += NGW) {
                f32x4* xr = (f32x4*)(out + (size_t)m * DM) + lane; const f32x4* gr = (const f32x4*)gf + lane;
                f32x4 v[4]; float s = 0.f;
#pragma unroll
                for (int j = 0; j < 4; ++j) { v[j] = xr[64 * j]; s += (v[j][0] * v[j][0] + v[j][1] * v[j][1]) + (v[j][2] * v[j][2] + v[j][3] * v[j][3]); }
                const float rstd = rsqrtf(wave_sum(s) * (1.f / DM) + EPS);
#pragma unroll
                for (int j = 0; j < 4; ++j) xr[64 * j] = v[j] * rstd * gr[64 * j];
            }
        } else {
            const int s1 = step - 1, hb = s1 / (DEPTH * ST_PER), l = (s1 / ST_PER) % DEPTH, ph = s1 % ST_PER;
            unsigned char* wl = ap->ws + WS_W + (size_t)l * W_LAYER;
            if (ph == 7 || (ph == 0 && l == 1)) continue;
            const int gt = bx * NTHREADS + tid, NT_ = G * NTHREADS;
            if (ph == 0) {
                rows_to_bf16(ap->in[0] + (size_t)hb * MH * DM, WSP(bf16_t, WS_H), WSP(float, WS_SSQ_X1), gw, NGW, lane);
                zero_f32(WSP(float, WS_SSQ_Q), MH, gt, NT_); zero_f32(WSP(float, WS_SSQ_KV), MH, gt, NT_);
            } else if (ph == 1) {
                pg8::Gemm g{WSP(bf16_t, WS_H), (const bf16_t*)(wl + WO_IN)};
                pg8::EpiInProj E{WSP(bf16_t, WS_P), ap->in[2] + (size_t)l * 3 * DM, WSP(float, WS_COS64), WSP(float, WS_SIN64), WSP(float, WS_COS32), WSP(float, WS_SIN32), WSP(float, WS_SSQ_Q), WSP(float, WS_SSQ_KV), WSP(float, WS_SSQ_X1)};
                pg8::gemm_phase<pg8::EpiInProj, true, MH, NIN, DM, DM, DM>(lds, tid, G, bx, g, E);
            } else if (ph == 2) {
                { pg8::Gemm g{WSP(bf16_t, WS_P) + PC_CQ, (const bf16_t*)(wl + WO_UQ)};
                  pg8::EpiUp E{WSP(bf16_t, WS_QC), 768, WSP(float, WS_SSQ_Q), 1.f / 768.f, 2, WSP(float, WS_COS32), WSP(float, WS_SIN32), 0.10206207261596577f * 1.4426950408889634f};
                  pg8::gemm_phase<pg8::EpiUp, true, MH, 768, 768, NIN, 768>(lds, tid, G, bx, g, E); }
                asm volatile("" : "+s"(ap));
                { pg8::Gemm g{WSP(bf16_t, WS_P) + PC_CKV, (const bf16_t*)(wl + WO_UKV)};
                  pg8::EpiUp E{WSP(bf16_t, WS_KVC), 1024, WSP(float, WS_SSQ_KV), 1.f / 256.f, -1, WSP(float, WS_COS32), WSP(float, WS_SIN32), 1.f};
                  pg8::gemm_phase<pg8::EpiUp, true, MH, 1024, 256, NIN, 256>(lds, tid, G, bx, g, E); }
                asm volatile("" : "+s"(ap));
            } else if (ph == 3) {
                zero_f32(WSP(float, WS_SSQ_X2), MH, gt, NT_); if (l == 0) zero_f32(WSP(float, WS_SSQ_X1), MH, gt, NT_);
                for (int u = vcu; u < 1024; u += G) {
                    const int b = u >> 8, mh = (u >> 5) & 7, qb = u & 31;
                    const bf16_t* pb = WSP(bf16_t, WS_P) + (size_t)b * SEQ * NIN;
                    att::attn_unit<64, 128, false, 1, NIN, 0, NIN, 0, NIN, DM>(pb + PC_DQ + mh * 64, nullptr, pb + PC_DK + mh * 64, nullptr, pb + PC_DV + (mh >> 1) * 128,
                        WSP(bf16_t, WS_OD) + (size_t)b * SEQ * DM + mh * 128, nullptr, qb * 256, 0, SEQ / 64, lds, tid);
                }
                for (int u = vcu; u < 1024; u += G) {
                    const int b = u >> 8, h = (u >> 5) & 7, qb = u & 31;
                    bf16_t* qb_ = WSP(bf16_t, WS_QC) + (size_t)b * SEQ * 768; const bf16_t* kb_ = WSP(bf16_t, WS_KVC) + (size_t)b * SEQ * 1024;
                    att::attn_unit<96, 64, false, 1, 768, 768, 1024, NIN, 1024, 768>(qb_ + h * 64, qb_ + 512 + h * 32, kb_ + h * 128, WSP(bf16_t, WS_P) + (size_t)b * SEQ * NIN + PC_KR, kb_ + h * 128 + 64,
                        qb_ + h * 64, nullptr, qb * 256, 0, SEQ / 64, lds, tid);
                }
                for (int u = vcu; u < 1536; u += G) {
                    const int b = u / 384, r = u % 384, h = r / 96, r2 = r % 96, g = r2 >> 5, w = r2 & 31;
                    const int dl = (g == 0) ? 1 : (g == 1 ? 4 : 16), nblk = 32 / dl, c = w / nblk, qb = w % nblk;
                    bf16_t* pb = WSP(bf16_t, WS_P) + ((size_t)b * SEQ + c) * NIN + PC_DIL + g * 768 + h * 64;
                    float* lp = WSP(float, WS_LSE) + (size_t)g * MH * 4 + ((size_t)b * SEQ + c) * 4 + h;
                    if (g == 0) att::attn_unit<64, 64, true, 1, NIN, 0, NIN, 0, NIN, NIN>(pb, nullptr, pb + 256, nullptr, pb + 512, pb, lp, qb * 256, qb * 256 - 64, 6, lds, tid);
                    else if (g == 1) att::attn_unit<64, 64, true, 4, NIN, 0, NIN, 0, NIN, NIN>(pb, nullptr, pb + 256, nullptr, pb + 512, pb, lp, qb * 256, qb * 256 - 64, 6, lds, tid);
                    else att::attn_unit<64, 64, true, 16, NIN, 0, NIN, 0, NIN, NIN>(pb, nullptr, pb + 256, nullptr, pb + 512, pb, lp, qb * 256, qb * 256 - 64, 6, lds, tid);
                }
            } else if (ph == 4) {
                const float* dlm = ap->in[4] + (size_t)l * 256; const float* gd = ap->in[5] + (size_t)l * 128;
                const float lam_init = 0.8f - 0.6f * expf(-0.3f * (float)l);
                const float s1_ = wave_sum(dlm[lane] * dlm[64 + lane]), s2_ = wave_sum(dlm[128 + lane] * dlm[192 + lane]);
                const float lam = expf(s1_) - expf(s2_) + lam_init;
                const int hh = lane >> 4, d8 = (lane & 15) * 8, d4 = (lane & 15) * 4;
                const bf16_t* OD = WSP(bf16_t, WS_OD); bf16_t* P = WSP(bf16_t, WS_P); const float* LSE = WSP(float, WS_LSE);
                const f32x4 gv0 = *(const f32x4*)(gd + d8) * (1.f - lam_init), gv1 = *(const f32x4*)(gd + d8 + 4) * (1.f - lam_init);
                for (int m = gw; m < MH; m += NGW) {
                    const u32x4 w1 = *(const u32x4*)(OD + (size_t)m * DM + (2 * hh) * 128 + d8), w2 = *(const u32x4*)(OD + (size_t)m * DM + (2 * hh + 1) * 128 + d8);
                    f32x4 ya, yb;
                    ya[0] = bf_lo(w1.x) - lam * bf_lo(w2.x); ya[1] = bf_hi(w1.x) - lam * bf_hi(w2.x); ya[2] = bf_lo(w1.y) - lam * bf_lo(w2.y); ya[3] = bf_hi(w1.y) - lam * bf_hi(w2.y);
                    yb[0] = bf_lo(w1.z) - lam * bf_lo(w2.z); yb[1] = bf_hi(w1.z) - lam * bf_hi(w2.z); yb[2] = bf_lo(w1.w) - lam * bf_lo(w2.w); yb[3] = bf_hi(w1.w) - lam * bf_hi(w2.w);
                    float ss = (ya[0] * ya[0] + ya[1] * ya[1]) + (ya[2] * ya[2] + ya[3] * ya[3]) + (yb[0] * yb[0] + yb[1] * yb[1]) + (yb[2] * yb[2] + yb[3] * yb[3]);
                    ss += __shfl_xor(ss, 1); ss += __shfl_xor(ss, 2); ss += __shfl_xor(ss, 4); ss += __shfl_xor(ss, 8);
                    const float rstd = rsqrtf(ss * (1.f / 128.f) + EPS);
                    ya = ya * rstd * gv0; yb = yb * rstd * gv1;
                    u32x4 ow; ow.x = pk2(ya[0], ya[1]); ow.y = pk2(ya[2], ya[3]); ow.z = pk2(yb[0], yb[1]); ow.w = pk2(yb[2], yb[3]);
                    const float l0 = LSE[(size_t)m * 4 + hh], l1 = LSE[(size_t)MH * 4 + (size_t)m * 4 + hh], l2 = LSE[(size_t)2 * MH * 4 + (size_t)m * 4 + hh];
                    const float lm = fmaxf(l0, fmaxf(l1, l2)); const float e0 = __expf(l0 - lm), e1 = __expf(l1 - lm), e2 = __expf(l2 - lm); const float ri = 1.f / (e0 + e1 + e2);
                    bf16_t* pr = P + (size_t)m * NIN + PC_DIL + hh * 64 + d4;
                    const u32x2 wv0 = *(const u32x2*)(pr), wv1 = *(const u32x2*)(pr + 768), wv2 = *(const u32x2*)(pr + 1536);
                    const float a0 = e0 * ri, a1 = e1 * ri, a2 = e2 * ri;
                    const float ob0 = a0 * bf_lo(wv0.x) + a1 * bf_lo(wv1.x) + a2 * bf_lo(wv2.x), ob1 = a0 * bf_hi(wv0.x) + a1 * bf_hi(wv1.x) + a2 * bf_hi(wv2.x);
                    const float ob2 = a0 * bf_lo(wv0.y) + a1 * bf_lo(wv1.y) + a2 * bf_lo(wv2.y), ob3 = a0 * bf_hi(wv0.y) + a1 * bf_hi(wv1.y) + a2 * bf_hi(wv2.y);
                    *(u32x4*)(P + (size_t)m * NIN + PC_DQ + hh * 128 + d8) = ow;
                    u32x2 o2; o2.x = pk2(ob0, ob1); o2.y = pk2(ob2, ob3); *(u32x2*)pr = o2;
                }
            } else if (ph == 5) {
                { pg8::Gemm g{WSP(bf16_t, WS_P) + PC_DQ, (const bf16_t*)(wl + WO_OD)}; pg8::EpiMerge<true> E{WSP(bf16_t, WS_MB), WSP(bf16_t, WS_P) + PC_GATE};
                  pg8::gemm_phase<pg8::EpiMerge<true>, true, MH, DM, 512, NIN, 512>(lds, tid, G, bx, g, E); }
                asm volatile("" : "+s"(ap));
                { pg8::Gemm g{WSP(bf16_t, WS_P) + PC_DIL, (const bf16_t*)(wl + WO_OL)}; pg8::EpiMerge<false> E{WSP(bf16_t, WS_MB), WSP(bf16_t, WS_P) + PC_GATE + DM};
                  pg8::gemm_phase<pg8::EpiMerge<false>, true, MH, DM, 256, NIN, 256>(lds, tid, G, bx, g, E); }
                asm volatile("" : "+s"(ap));
                { pg8::Gemm g{WSP(bf16_t, WS_QC), (const bf16_t*)(wl + WO_OM)}; pg8::EpiMerge<false> E{WSP(bf16_t, WS_MB), WSP(bf16_t, WS_P) + PC_GATE + 2 * DM};
                  pg8::gemm_phase<pg8::EpiMerge<false>, true, MH, DM, 512, 768, 512>(lds, tid, G, bx, g, E); }
                asm volatile("" : "+s"(ap));
            } else if (ph == 6) {
                pg8::Gemm g{WSP(bf16_t, WS_MB), (const bf16_t*)(wl + WO_OUT)};
                pg8::EpiResid<true> E{(l == 0 ? ap->in[0] : ap->out) + (size_t)hb * MH * DM, ap->out + (size_t)hb * MH * DM, WSP(bf16_t, WS_H), WSP(float, WS_SSQ_X2)};
                pg8::gemm_phase<pg8::EpiResid<true>, true, MH, DM, DM, DM, DM>(lds, tid, G, bx, g, E);
            } else if (ph == 8) {
                pg8::Gemm g{WSP(bf16_t, WS_H), (const bf16_t*)(wl + WO_UP)};
                zero_f32(WSP(float, WS_SSQ_Q), MH, gt, NT_); zero_f32(WSP(float, WS_SSQ_KV), MH, gt, NT_);
                pg8::EpiSqRelu E{WSP(bf16_t, WS_P), FF, WSP(float, WS_SSQ_X2)};
                pg8::gemm_phase<pg8::EpiSqRelu, true, MH, FF, DM, DM, DM>(lds, tid, G, bx, g, E);
            } else {
                pg8::Gemm g{WSP(bf16_t, WS_P), (const bf16_t*)(wl + WO_DN)};
                if (l == 0) { pg8::EpiResid<true> E{ap->out + (size_t)hb * MH * DM, ap->out + (size_t)hb * MH * DM, WSP(bf16_t, WS_H), WSP(float, WS_SSQ_X1)};
                              pg8::gemm_phase<pg8::EpiResid<true>, true, MH, DM, FF, FF, FF>(lds, tid, G, bx, g, E); }
                else        { pg8::EpiResid<false> E{ap->out + (size_t)hb * MH * DM, ap->out + (size_t)hb * MH * DM, nullptr, nullptr};
                              pg8::gemm_phase<pg8::EpiResid<false>, true, MH, DM, FF, FF, FF>(lds, tid, G, bx, g, E); }
            }
        }
        if (step + 1 < step_hi) { if (step_lo < 0) grid.sync(); else { XcdBarrier xb_; xb_.bar = WSP(unsigned, WS_BAR); xb_.x = xb_xcc_id(); xb_.st = (volatile LAS unsigned*)(lds + XB_LDS_OFF); xcd_barrier(xb_); } }
    }
}

extern "C" void kernel_launch(void* const* d_in, const int* in_sizes, int n_in, void* d_out, int out_size, void* d_ws, size_t ws_size, hipStream_t stream) {
    static int grid = 0;
    if (grid == 0) {
        if (n_in != 18 || out_size != MTOT * DM || ws_size < WS_END) { fprintf(stderr, "kernel_launch: unexpected shapes (n_in %d out %d ws %zu)\n", n_in, out_size, ws_size); grid = -1; return; }
        int dev = 0, cus = 0, per_cu = 0;
        (void)hipGetDevice(&dev); (void)hipDeviceGetAttribute(&cus, hipDeviceAttributeMultiprocessorCount, dev);
        if (hipFuncSetAttribute((const void*)mk_fwd, hipFuncAttributeMaxDynamicSharedMemorySize, LDS_BYTES) != hipSuccess) { fprintf(stderr, "hipFuncSetAttribute failed\n"); grid = -1; return; }
        (void)hipOccupancyMaxActiveBlocksPerMultiprocessor(&per_cu, (const void*)mk_fwd, NTHREADS, LDS_BYTES);
        (void)hipGetLastError();
        if (per_cu < 1) per_cu = 1;
        grid = cus * 1;
        fprintf(stderr, "kernel_launch: grid %d (occupancy query %d/CU)\n", grid, per_cu);
    }
    if (grid < 0) return;
    if (hipMemsetAsync((char*)d_ws + WS_BAR, 0, 16384, stream) != hipSuccess) { fprintf(stderr, "kernel_launch: hipMemsetAsync failed\n"); return; }
    Args a{};
    for (int i = 0; i < 18; ++i) a.in[i] = (const float*)d_in[i];
    a.out = (float*)d_out; a.ws = (unsigned char*)d_ws;
#if MK_MULTI
    for (int s = 0; s < NSTEPS; ++s) { a.lo = s; a.hi = s + 1; void* kargs[] = {&a};
        hipError_t e = hipLaunchCooperativeKernel((const void*)mk_fwd, dim3(grid), dim3(NTHREADS), kargs, LDS_BYTES, stream);
        if (e != hipSuccess) { fprintf(stderr, "launch step %d failed: %s\n", s, hipGetErrorString(e)); break; } }
#else
    a.lo = 0; a.hi = NSTEPS; void* kargs[] = {&a};
    hipError_t e = hipLaunchCooperativeKernel((const void*)mk_fwd, dim3(grid), dim3(NTHREADS), kargs, LDS_BYTES, stream);
    if (e != hipSuccess) fprintf(stderr, "cooperative launch failed: %s (grid %d)\n", hipGetErrorString(e), grid);
#endif
}
```

```cpp
#include <hip/hip_runtime.h>
#include <hip/hip_cooperative_groups.h>
#include <cstdio>
#include <cstdint>
namespace cg = cooperative_groups;

#ifndef MK_MULTI
#define MK_MULTI 0
#endif

#define LAS __attribute__((address_space(3)))
typedef unsigned short bf16_t;
typedef short bf16x8 __attribute__((ext_vector_type(8)));
typedef short s16x4 __attribute__((ext_vector_type(4)));
typedef float f32x4 __attribute__((ext_vector_type(4)));
typedef float f32x16 __attribute__((ext_vector_type(16)));
typedef unsigned u32x4 __attribute__((ext_vector_type(4)));
typedef unsigned u32x2 __attribute__((ext_vector_type(2)));

constexpr int SEQ = 8192, DM = 1024, MTOT = 65536, MH = 32768, NHALF = 2, DEPTH = 2;
constexpr int NIN = 8192;
constexpr int INC = 7968;
constexpr int FF = 4096;
constexpr float EPS = 1e-6f;
constexpr int PC_DQ = 0, PC_DK = 512, PC_DV = 1024, PC_DIL = 1536, PC_CQ = 3840, PC_CKV = 4608, PC_KR = 4864, PC_GATE = 5120;

constexpr size_t MiB = 1u << 20;
constexpr size_t WS_SSQ_Q = 0, WS_SSQ_KV = 128 * 1024, WS_SSQ_X1 = 256 * 1024, WS_SSQ_X2 = 384 * 1024;
constexpr size_t WS_BAR = 512 * 1024;
constexpr size_t WS_COS64 = 1 * MiB, WS_SIN64 = 2 * MiB, WS_COS32 = 3 * MiB, WS_SIN32 = 3 * MiB + 512 * 1024;
constexpr size_t WS_W = 4 * MiB, W_LAYER = 40 * MiB;
constexpr size_t WO_IN = 0, WO_UQ = 16 * MiB, WO_UKV = 18 * MiB, WO_OD = 19 * MiB, WO_OL = 20 * MiB, WO_OM = 21 * MiB, WO_OUT = 22 * MiB, WO_UP = 24 * MiB, WO_DN = 32 * MiB;
constexpr size_t WS_H = 84 * MiB;
constexpr size_t WS_P = 148 * MiB;
constexpr size_t WS_QC = 660 * MiB;
constexpr size_t WS_KVC = 708 * MiB;
constexpr size_t WS_OD = 772 * MiB;
constexpr size_t WS_MB = 836 * MiB;
constexpr size_t WS_LSE = 900 * MiB;
constexpr size_t WS_END = 902 * MiB;

__device__ __forceinline__ unsigned cvt_pk_bf16(float lo, float hi) { unsigned r; asm volatile("v_cvt_pk_bf16_f32 %0, %1, %2" : "=v"(r) : "v"(lo), "v"(hi)); return r; }
__device__ __forceinline__ float bf_lo(unsigned u) { return __uint_as_float(u << 16); }
__device__ __forceinline__ float bf_hi(unsigned u) { return __uint_as_float(u & 0xffff0000u); }

namespace pg8 {
constexpr int BM = 256, BK = 64, HALF = 128, HTB = HALF * BK * 2, STAGE_BYTES = 8 * HTB, NXCD = 8, WGM = 8;
__host__ __device__ __forceinline__ int lds_byte(int r, int c) { const int st = (r >> 4) * 2 + (c >> 5), rr = r & 15, cc = c & 31, ob = rr * 64 + cc * 2; return st * 1024 + (ob ^ (((ob >> 9) & 1) << 5)); }
__host__ __device__ __forceinline__ void stage_rc(int b, int& R, int& C) { const int st = b / 1024, sb = b % 1024, swz = sb ^ (((sb >> 9) & 1) << 5); R = (st >> 1) * 16 + swz / 64; C = (st & 1) * 32 + (swz % 64) / 2; }
__host__ __device__ __forceinline__ int perm32(int rho) { const int n = rho >> 4, i = rho & 15; return 8 * (i >> 2) + 4 * n + (i & 3); }

struct Unit { int pm, pn; };
struct Gemm { const bf16_t* A; const bf16_t* Bt; };

struct StaticOrder {
    int nM, nN, nwg, G, c;
    __host__ __device__ void init(int M, int N, int G_, int c_) { nM = M / BM; nN = N / BM; nwg = nM * nN; G = G_; c = c_; }
    __host__ __device__ bool next(int i, Unit& u) const {
        const long L = (long)i * G + c; if (L >= nwg) return false;
        int wgid = (int)L; { const int q = nwg / NXCD, r = nwg % NXCD, xcd = wgid % NXCD, off = wgid / NXCD; wgid = (xcd < r ? xcd * (q + 1) : r * (q + 1) + (xcd - r) * q) + off; }
        const int nig = WGM * nN, gid = wgid / nig, fm = gid * WGM, gsz = (nM - fm) < WGM ? (nM - fm) : WGM;
        u.pm = fm + ((wgid % nig) % gsz); u.pn = (wgid % nig) / gsz; return true;
    }
};

template <class Epi, bool ALIGN_EPI, int M_, int N_, int K_, int LDA, int LDB>
__device__ __forceinline__ void gemm_phase(LAS unsigned char* lds, const int tid_in, const int G_in, const int bx_in, const Gemm g, const Epi& E) {
    int tid = tid_in; asm volatile("" : "+v"(tid));
    int Gl = G_in, bxl = bx_in; asm volatile("" : "+s"(Gl), "+s"(bxl));
    StaticOrder S; S.init(M_, N_, Gl, bxl);
    const int wid = __builtin_amdgcn_readfirstlane(tid >> 6), lane = tid & 63, wr = wid >> 2, wc = wid & 3, fr = lane & 15, fq = lane >> 4;
    constexpr int nt = K_ / BK;
    unsigned voffA[2], voffB[2];
#pragma unroll
    for (int i = 0; i < 2; ++i) { int R, C; stage_rc(tid * 16 + i * 8192, R, C); const int Rb = Epi::PERM ? ((R & ~31) + perm32(R & 31)) : R;
        voffA[i] = (unsigned)(R * LDA + C) * 2u; voffB[i] = (unsigned)(Rb * LDB + C) * 2u; }
    constexpr size_t kstep = (size_t)(BK * 2);
    constexpr size_t hstepA = (size_t)HALF * LDA * 2, hstepB = (size_t)HALF * LDB * 2;
    constexpr size_t tstepA = 2 * hstepA, tstepB = 2 * hstepB;
    const unsigned ldsw = (unsigned)wid * 1024u;
    const int aoff = lds_byte(wr * 64 + fr, fq * 8), boff = lds_byte(wc * 32 + fr, fq * 8);
#define PG8_SA(b, h) (((b) * 2 + (h)) * HTB)
#define PG8_SB(b, h) ((4 + (b) * 2 + (h)) * HTB)
#define PG8_STAGE(bufoff, gbase, voff) do { _Pragma("unroll") for (int _i = 0; _i < 2; ++_i) \
        __builtin_amdgcn_global_load_lds((const unsigned*)((const char*)(gbase) + (voff)[_i]), (LAS unsigned*)(lds + (bufoff) + ldsw + _i * 8192), 16, 0, 0); } while (0)
#define PG8_LDA(dst, b, h) do { _Pragma("unroll") for (int m = 0; m < 4; ++m) _Pragma("unroll") for (int k = 0; k < 2; ++k) dst[m][k] = *(const LAS bf16x8*)(lds + PG8_SA(b, h) + aoff + m * 2048 + k * 1024); } while (0)
#define PG8_LDB(dst, b, h) do { _Pragma("unroll") for (int n = 0; n < 2; ++n) _Pragma("unroll") for (int k = 0; k < 2; ++k) dst[n][k] = *(const LAS bf16x8*)(lds + PG8_SB(b, h) + boff + n * 2048 + k * 1024); } while (0)
#define PG8_MMA(ai, bj, At, Bt) do { __builtin_amdgcn_s_setprio(1); _Pragma("unroll") for (int m = 0; m < 4; ++m) _Pragma("unroll") for (int n = 0; n < 2; ++n) _Pragma("unroll") for (int k = 0; k < 2; ++k) \
        acc[ai][bj][m][n] = __builtin_amdgcn_mfma_f32_16x16x32_bf16(Bt[n][k], At[m][k], acc[ai][bj][m][n], 0, 0, 0); __builtin_amdgcn_s_setprio(0); } while (0)
#define PG8_WAIT_V(n) asm volatile("s_waitcnt vmcnt(" #n ")" ::: "memory")
#define PG8_WAIT_L(n) asm volatile("s_waitcnt lgkmcnt(" #n ")" ::: "memory")
#define PG8_BAR __builtin_amdgcn_s_barrier()
#define PG8_SCHED __builtin_amdgcn_sched_barrier(0)
    Unit cur, nxt; int ui = 0;
    if (!S.next(0, cur)) return;
    f32x4 acc[2][2][4][2];
#pragma unroll
    for (int a = 0; a < 2; ++a)
#pragma unroll
        for (int b = 0; b < 2; ++b)
#pragma unroll
            for (int m = 0; m < 4; ++m)
#pragma unroll
                for (int n = 0; n < 2; ++n) acc[a][b][m][n] = (f32x4){0.f, 0.f, 0.f, 0.f};
    bf16x8 At[4][2], B0[2][2], B1[2][2];
    const char* cA = (const char*)g.A + (size_t)cur.pm * tstepA; const char* cB = (const char*)g.Bt + (size_t)cur.pn * tstepB;
    PG8_STAGE(PG8_SB(0, 0), cB, voffB); PG8_STAGE(PG8_SB(0, 1), cB + hstepB, voffB); PG8_STAGE(PG8_SA(0, 0), cA, voffA); PG8_STAGE(PG8_SA(0, 1), cA + hstepA, voffA);
    if (wr == 1) PG8_BAR;
    PG8_WAIT_V(2); PG8_BAR;
    PG8_STAGE(PG8_SB(1, 0), cB + kstep, voffB); PG8_STAGE(PG8_SA(1, 0), cA + kstep, voffA); PG8_STAGE(PG8_SB(1, 1), cB + hstepB + kstep, voffB);
    PG8_WAIT_V(6); PG8_BAR;
    for (;;) {
        const bool has_next = S.next(ui + 1, nxt);
        const char* nA = has_next ? (const char*)g.A + (size_t)nxt.pm * tstepA : cA; const char* nB = has_next ? (const char*)g.Bt + (size_t)nxt.pn * tstepB : cB;
#pragma nounroll
        for (int t = 0; t < nt; t += 2) {
            const bool last = (t == nt - 2);
            const char* a1 = cA + (size_t)(t + 1) * kstep;
            const char* a2 = last ? nA : cA + (size_t)(t + 2) * kstep; const char* b2 = last ? nB : cB + (size_t)(t + 2) * kstep;
            const char* a3 = a2 + kstep; const char* b3 = b2 + kstep;
            PG8_LDB(B0, 0, 0); PG8_LDB(B1, 0, 1); PG8_SCHED; PG8_LDA(At, 0, 0); PG8_STAGE(PG8_SA(1, 1), a1 + hstepA, voffA);
            PG8_WAIT_V(8); PG8_WAIT_L(0); PG8_BAR; PG8_MMA(0, 0, At, B0); PG8_MMA(0, 1, At, B1); PG8_BAR; PG8_SCHED;
            PG8_LDA(At, 0, 1); PG8_STAGE(PG8_SB(0, 0), b2, voffB); PG8_STAGE(PG8_SB(0, 1), b2 + hstepB, voffB); PG8_STAGE(PG8_SA(0, 0), a2, voffA);
            PG8_WAIT_V(8); PG8_WAIT_L(0); PG8_BAR; PG8_MMA(1, 0, At, B0); PG8_MMA(1, 1, At, B1); PG8_BAR; PG8_SCHED;
            PG8_LDB(B0, 1, 0); PG8_LDB(B1, 1, 1); PG8_SCHED; PG8_LDA(At, 1, 0); PG8_STAGE(PG8_SA(0, 1), a2 + hstepA, voffA);
            PG8_WAIT_V(8); PG8_WAIT_L(0); PG8_BAR; PG8_MMA(0, 0, At, B0); PG8_MMA(0, 1, At, B1); PG8_BAR; PG8_SCHED;
            PG8_LDA(At, 1, 1); PG8_STAGE(PG8_SB(1, 0), b3, voffB); PG8_STAGE(PG8_SB(1, 1), b3 + hstepB, voffB); PG8_STAGE(PG8_SA(1, 0), a3, voffA);
            PG8_WAIT_V(8); PG8_WAIT_L(0); PG8_BAR; PG8_MMA(1, 0, At, B0); PG8_MMA(1, 1, At, B1); PG8_BAR; PG8_SCHED;
        }
        if constexpr (ALIGN_EPI) { if (wr == 0) PG8_BAR; }
        E(acc, cur, wr, wc, fr, fq);
        if (!has_next) break;
#pragma unroll
        for (int a = 0; a < 2; ++a)
#pragma unroll
            for (int b = 0; b < 2; ++b)
#pragma unroll
                for (int m = 0; m < 4; ++m)
#pragma unroll
                    for (int n = 0; n < 2; ++n) acc[a][b][m][n] = (f32x4){0.f, 0.f, 0.f, 0.f};
        cur = nxt; cA = nA; cB = nB; ++ui;
        if constexpr (ALIGN_EPI) { if (wr == 1) PG8_BAR; }
    }
    PG8_WAIT_V(0);
    if constexpr (!ALIGN_EPI) { if (wr == 0) PG8_BAR; }
    PG8_BAR;
#undef PG8_SA
#undef PG8_SB
#undef PG8_STAGE
#undef PG8_LDA
#undef PG8_LDB
#undef PG8_MMA
#undef PG8_WAIT_V
#undef PG8_WAIT_L
#undef PG8_BAR
#undef PG8_SCHED
}

__device__ __forceinline__ void store8(bf16_t* p, f32x4 v0, f32x4 v1) {
    u32x4 w; w.x = cvt_pk_bf16(v0[0], v0[1]); w.y = cvt_pk_bf16(v0[2], v0[3]); w.z = cvt_pk_bf16(v1[0], v1[1]); w.w = cvt_pk_bf16(v1[2], v1[3]); *(u32x4*)p = w;
}
struct EpiInProj {
    static constexpr bool PERM = true;
    bf16_t* P; const float* bgate; const float *cos64, *sin64, *cos32, *sin32; float *ssq_q, *ssq_kv; const float* ssq_x;
    __device__ __forceinline__ void operator()(const f32x4 (&acc)[2][2][4][2], const Unit& u, int wr, int wc, int fr, int fq) const {
        const int pn = u.pn; int type;
        if (pn < 4) type = 0; else if (pn < 6) type = 1; else if (pn < 15) type = ((pn - 6) % 3 < 2) ? 0 : 1; else if (pn < 18) type = 2; else if (pn == 18) type = 3; else if (pn == 19) type = 4; else type = 5;
        const int row0 = u.pm * BM + wr * 64 + fr, col0 = pn * BM + wc * 32 + 8 * fq;
        const float qs = (pn < 2 || (pn >= 6 && pn < 15 && (pn - 6) % 3 == 0)) ? 0.125f * 1.4426950408889634f : 1.f;
#pragma unroll
        for (int ai = 0; ai < 2; ++ai)
#pragma unroll
            for (int m = 0; m < 4; ++m) {
                const int row = row0 + ai * HALF + m * 16, pos = row & (SEQ - 1);
                bf16_t* rowp = P + (size_t)row * NIN + col0;
                const float rstd = rsqrtf(ssq_x[row] * (1.f / DM) + EPS);
                float ss = 0.f;
                f32x4 c4 = (f32x4){1.f, 1.f, 1.f, 1.f}, s4 = (f32x4){0.f, 0.f, 0.f, 0.f};
                if (type == 0) { const int a = 4 * (wc & 1) + fq; c4 = *(const f32x4*)(cos64 + pos * 32 + 4 * a); s4 = *(const f32x4*)(sin64 + pos * 32 + 4 * a); }
                else if (type == 4) { c4 = *(const f32x4*)(cos32 + pos * 16 + 4 * fq); s4 = *(const f32x4*)(sin32 + pos * 16 + 4 * fq); }
#pragma unroll
                for (int bj = 0; bj < 2; ++bj) {
                    f32x4 v0 = acc[ai][bj][m][0] * rstd, v1 = acc[ai][bj][m][1] * rstd;
                    if (type == 0 || type == 4) { const f32x4 lo = v0 * c4 - v1 * s4, hi_ = v1 * c4 + v0 * s4; v0 = lo * qs; v1 = hi_ * qs; }
                    else if (type == 2 || type == 3) { ss += (v0[0] * v0[0] + v0[1] * v0[1]) + (v0[2] * v0[2] + v0[3] * v0[3]) + (v1[0] * v1[0] + v1[1] * v1[1]) + (v1[2] * v1[2] + v1[3] * v1[3]); }
                    else if (type == 5) { const float* bp = bgate + (col0 + bj * HALF - PC_GATE); const f32x4 b0 = *(const f32x4*)bp, b1 = *(const f32x4*)(bp + 4);
#pragma unroll
                        for (int e = 0; e < 4; ++e) { v0[e] = __builtin_amdgcn_rcpf(1.f + __builtin_amdgcn_exp2f(-1.4426950408889634f * (v0[e] + b0[e]))); v1[e] = __builtin_amdgcn_rcpf(1.f + __builtin_amdgcn_exp2f(-1.4426950408889634f * (v1[e] + b1[e]))); } }
                    store8(rowp + bj * HALF, v0, v1);
                }
                if (type == 2 || type == 3) { ss += __shfl_xor(ss, 16); ss += __shfl_xor(ss, 32);
                    if (fq == 0) __hip_atomic_fetch_add((type == 2 ? ssq_q : ssq_kv) + row, ss, __ATOMIC_RELAXED, __HIP_MEMORY_SCOPE_AGENT); }
                asm volatile("" ::: "memory");
            }
    }
};
struct EpiUp {
    static constexpr bool PERM = true;
    bf16_t* O; int ldo; const float* ssq; float inv_n; int rope_tile; const float *cos32, *sin32; float oscale;
    __device__ __forceinline__ void operator()(const f32x4 (&acc)[2][2][4][2], const Unit& u, int wr, int wc, int fr, int fq) const {
        const int row0 = u.pm * BM + wr * 64 + fr, col0 = u.pn * BM + wc * 32 + 8 * fq; const bool rope = (u.pn == rope_tile);
#pragma unroll
        for (int ai = 0; ai < 2; ++ai)
#pragma unroll
            for (int m = 0; m < 4; ++m) {
                const int row = row0 + ai * HALF + m * 16, pos = row & (SEQ - 1);
                const float rstd = rsqrtf(ssq[row] * inv_n + EPS) * oscale;
                f32x4 c4 = (f32x4){1.f, 1.f, 1.f, 1.f}, s4 = (f32x4){0.f, 0.f, 0.f, 0.f};
                if (rope) { c4 = *(const f32x4*)(cos32 + pos * 16 + 4 * fq); s4 = *(const f32x4*)(sin32 + pos * 16 + 4 * fq); }
#pragma unroll
                for (int bj = 0; bj < 2; ++bj) {
                    f32x4 v0 = acc[ai][bj][m][0] * rstd, v1 = acc[ai][bj][m][1] * rstd;
                    if (rope) { const f32x4 lo = v0 * c4 - v1 * s4, hi_ = v1 * c4 + v0 * s4; v0 = lo; v1 = hi_; }
                    store8(O + (size_t)row * ldo + col0 + bj * HALF, v0, v1);
                }
                asm volatile("" ::: "memory");
            }
    }
};
template <bool FIRST> struct EpiMerge {
    static constexpr bool PERM = true;
    bf16_t* MBp; const bf16_t* G;
    __device__ __forceinline__ void operator()(const f32x4 (&acc)[2][2][4][2], const Unit& u, int wr, int wc, int fr, int fq) const {
        const int row0 = u.pm * BM + wr * 64 + fr, col0 = u.pn * BM + wc * 32 + 8 * fq;
#pragma unroll
        for (int ai = 0; ai < 2; ++ai)
#pragma unroll
            for (int m = 0; m < 4; ++m) {
                const int row = row0 + ai * HALF + m * 16;
#pragma unroll
                for (int bj = 0; bj < 2; ++bj) {
                    const u32x4 gw = *(const u32x4*)(G + (size_t)row * NIN + col0 + bj * HALF);
                    bf16_t* mp = MBp + (size_t)row * DM + col0 + bj * HALF;
                    f32x4 o0 = (f32x4){0.f, 0.f, 0.f, 0.f}, o1 = o0;
                    if (!FIRST) { const u32x4 ow = *(const u32x4*)mp; o0 = (f32x4){bf_lo(ow.x), bf_hi(ow.x), bf_lo(ow.y), bf_hi(ow.y)}; o1 = (f32x4){bf_lo(ow.z), bf_hi(ow.z), bf_lo(ow.w), bf_hi(ow.w)}; }
                    const f32x4 g0 = (f32x4){bf_lo(gw.x), bf_hi(gw.x), bf_lo(gw.y), bf_hi(gw.y)}, g1 = (f32x4){bf_lo(gw.z), bf_hi(gw.z), bf_lo(gw.w), bf_hi(gw.w)};
                    store8(mp, o0 + g0 * acc[ai][bj][m][0], o1 + g1 * acc[ai][bj][m][1]);
                }
                asm volatile("" ::: "memory");
            }
    }
};
template <bool STATS> struct EpiResid {
    static constexpr bool PERM = false;
    const float* src; float* dst; bf16_t* H; float* ssq;
    __device__ __forceinline__ void operator()(const f32x4 (&acc)[2][2][4][2], const Unit& u, int wr, int wc, int fr, int fq) const {
        const int row0 = u.pm * BM + wr * 64 + fr, col0 = u.pn * BM + wc * 32 + 4 * fq;
#pragma unroll
        for (int ai = 0; ai < 2; ++ai)
#pragma unroll
            for (int m = 0; m < 4; ++m) { const int row = row0 + ai * HALF + m * 16; const size_t off = (size_t)row * DM + col0; float ss = 0.f;
#pragma unroll
                for (int bj = 0; bj < 2; ++bj)
#pragma unroll
                    for (int n = 0; n < 2; ++n) { const f32x4 b = *(const f32x4*)(src + off + bj * HALF + n * 16); const f32x4 v = b + acc[ai][bj][m][n]; *(f32x4*)(dst + off + bj * HALF + n * 16) = v;
                        if constexpr (STATS) { u32x2 w; w.x = cvt_pk_bf16(v[0], v[1]); w.y = cvt_pk_bf16(v[2], v[3]); *(u32x2*)(H + off + bj * HALF + n * 16) = w;
                            ss += (v[0] * v[0] + v[1] * v[1]) + (v[2] * v[2] + v[3] * v[3]); } }
                if constexpr (STATS) { ss += __shfl_xor(ss, 16); ss += __shfl_xor(ss, 32); if (fq == 0) __hip_atomic_fetch_add(ssq + row, ss, __ATOMIC_RELAXED, __HIP_MEMORY_SCOPE_AGENT); }
                asm volatile("" ::: "memory"); }
    }
};
struct EpiSqRelu {
    static constexpr bool PERM = true;
    bf16_t* O; int ldo; const float* ssq;
    __device__ __forceinline__ void operator()(const f32x4 (&acc)[2][2][4][2], const Unit& u, int wr, int wc, int fr, int fq) const {
        const int row0 = u.pm * BM + wr * 64 + fr, col0 = u.pn * BM + wc * 32 + 8 * fq;
#pragma unroll
        for (int ai = 0; ai < 2; ++ai)
#pragma unroll
            for (int m = 0; m < 4; ++m) { const int row = row0 + ai * HALF + m * 16; bf16_t* rowp = O + (size_t)row * ldo + col0; const float rstd = rsqrtf(ssq[row] * (1.f / DM) + EPS);
#pragma unroll
                for (int bj = 0; bj < 2; ++bj) { f32x4 v0 = acc[ai][bj][m][0], v1 = acc[ai][bj][m][1];
#pragma unroll
                    for (int e = 0; e < 4; ++e) { const float a = fmaxf(v0[e], 0.f) * rstd, b = fmaxf(v1[e], 0.f) * rstd; v0[e] = a * a; v1[e] = b * b; }
                    store8(rowp + bj * HALF, v0, v1); } }
    }
};
}

namespace att {
constexpr int KB0 = 0, KBSZ = 12288, VB0 = 2 * KBSZ, VBSZ = 16384, WSF_OFF = VB0 + 2 * VBSZ;
constexpr float THR = 8.f;
__device__ __forceinline__ int crow(int r, int hi) { return (r & 3) + 8 * (r >> 2) + 4 * hi; }
typedef short v4i16_t __attribute__((ext_vector_type(4)));
typedef float f32x2 __attribute__((ext_vector_type(2)));
__device__ __forceinline__ s16x4 vtr(const LAS unsigned char* p) { return __builtin_bit_cast(s16x4, __builtin_amdgcn_ds_read_tr16_b64_v4i16((LAS v4i16_t*)p)); }
__device__ __forceinline__ float max3f(float a, float b, float c) { return __builtin_fmaxf(__builtin_fmaxf(a, b), c); }

template <int DQK, int DV, bool DIL, int dl, int SQ0, int SQ1, int SK0, int SK1, int SV, int SO>
__device__ __forceinline__ void attn_unit(const bf16_t* Q0, const bf16_t* Q1, const bf16_t* K0, const bf16_t* K1, const bf16_t* V, bf16_t* O, float* L,
                                          const int q0, const int kv_lo, const int nt, LAS unsigned char* lds, const int tid) {
    constexpr int ND0 = DQK / 16, NDB = DV / 32, nseq = SEQ / dl;
    constexpr bool FILLM = (DV == 128);
    constexpr bool NEGM = true;
    const int lane = tid & 63, r32 = lane & 31, hi = lane >> 5; const int wid = __builtin_amdgcn_readfirstlane(tid >> 6);
    LAS float* wsf = (LAS float*)(lds + WSF_OFF) + wid * 64;
    const int qrow = q0 + wid * 32 + r32;
    bf16x8 qf[ND0];
#pragma unroll
    for (int d0 = 0; d0 < 4; ++d0) qf[d0] = *(const bf16x8*)(Q0 + (size_t)qrow * (size_t)(SQ0 * dl) + d0 * 16 + hi * 8);
    if constexpr (DQK == 96) {
#pragma unroll
        for (int d0 = 4; d0 < 6; ++d0) qf[d0] = *(const bf16x8*)(Q1 + (size_t)qrow * (size_t)(SQ1 * dl) + (d0 - 4) * 16 + hi * 8);
    }
    f32x16 o[NDB];
#pragma unroll
    for (int i = 0; i < NDB; ++i) o[i] = (f32x16){0.f, 0.f, 0.f, 0.f, 0.f, 0.f, 0.f, 0.f, 0.f, 0.f, 0.f, 0.f, 0.f, 0.f, 0.f, 0.f};
    const f32x16 zero16 = (f32x16){0.f, 0.f, 0.f, 0.f, 0.f, 0.f, 0.f, 0.f, 0.f, 0.f, 0.f, 0.f, 0.f, 0.f, 0.f, 0.f};
    f32x16 negm = zero16;
    float mrow = 0.f; f32x2 lacc = (f32x2){0.f, 0.f};
    u32x4 sk0, sk1, sv0, sv1;
    sk1 = (u32x4){0u, 0u, 0u, 0u}; sv1 = sk1;
    const int vlane_off = ((lane >> 4) & 1) * 32 + (lane & 3) * 8 + (4 * hi + ((lane & 15) >> 2)) * 64;
#define ATT_LOADK(t) do { \
        int kr_ = kv_lo + (t) * 64 + lane; if constexpr (DIL) kr_ = kr_ < 0 ? 0 : (kr_ >= nseq ? nseq - 1 : kr_); \
        sk0 = *(const u32x4*)(K0 + (size_t)kr_ * (size_t)(SK0 * dl) + wid * 8); \
        if constexpr (DQK == 96) { if (wid < 4) sk1 = *(const u32x4*)(K1 + (size_t)kr_ * (size_t)(SK1 * dl) + wid * 8); } \
    } while (0)
#define ATT_LOADV(t) do { \
        int vr_ = kv_lo + (t) * 64 + 16 * (wid & 3) + (lane >> 2); if constexpr (DIL) vr_ = vr_ < 0 ? 0 : (vr_ >= nseq ? nseq - 1 : vr_); \
        sv0 = *(const u32x4*)(V + (size_t)vr_ * (size_t)(SV * dl) + (wid >> 2) * 32 + (lane & 3) * 8); \
        if constexpr (DV == 128) sv1 = *(const u32x4*)(V + (size_t)vr_ * (size_t)(SV * dl) + (2 + (wid >> 2)) * 32 + (lane & 3) * 8); \
    } while (0)
#define ATT_STOREK(b) do { LAS unsigned char* kb_ = lds + KB0 + (b) * KBSZ; \
        *(LAS u32x4*)(kb_ + wid * 1024 + lane * 16) = sk0; \
        if constexpr (DQK == 96) { if (wid < 4) *(LAS u32x4*)(kb_ + (8 + wid) * 1024 + lane * 16) = sk1; } \
    } while (0)
#define ATT_STOREV(b) do { LAS unsigned char* vb_ = lds + VB0 + (b) * VBSZ; \
        *(LAS u32x4*)(vb_ + wid * 1024 + lane * 16) = sv0; \
        if constexpr (DV == 128) *(LAS u32x4*)(vb_ + (8 + wid) * 1024 + lane * 16) = sv1; \
    } while (0)
#define ATT_NEED(t) (!DIL || ((64 * (t) < 32 * wid + 160) && (64 * (t) + 64 > 32 * wid)))
#define ATT_SB() __builtin_amdgcn_sched_barrier(0)
#define ATT_RESC(P0, P1, MX) do { if (__any(MX > (NEGM ? THR : mrow + THR))) { \
        const float mxr_ = __builtin_fmaxf(MX, __shfl_xor(MX, 32)); const float dlt_ = __builtin_fmaxf(NEGM ? mxr_ : mxr_ - mrow, 0.f); \
        mrow += dlt_; const float f_ = __builtin_amdgcn_exp2f(-dlt_); lacc = lacc * f_; \
        _Pragma("unroll") for (int r = 0; r < 16; ++r) { P0[r] -= dlt_; P1[r] -= dlt_; if constexpr (!FILLM) negm[r] = -mrow; } \
        __builtin_amdgcn_wave_barrier(); if (hi == 0) wsf[r32] = f_; __builtin_amdgcn_wave_barrier(); \
        _Pragma("unroll") for (int g4 = 0; g4 < 4; ++g4) { const f32x4 fv = *(const LAS f32x4*)(wsf + 8 * g4 + 4 * hi); \
            _Pragma("unroll") for (int i = 0; i < NDB; ++i) { o[i][4 * g4 + 0] *= fv[0]; o[i][4 * g4 + 1] *= fv[1]; o[i][4 * g4 + 2] *= fv[2]; o[i][4 * g4 + 3] *= fv[3]; } } \
        __builtin_amdgcn_wave_barrier(); } } while (0)
#define ATT_EXPP(P0, P1, e) do { \
        f32x2 a_ = (f32x2){P0[2 * (e)], P0[2 * (e) + 1]}, b_ = (f32x2){P1[2 * (e)], P1[2 * (e) + 1]}; \
        a_[0] = __builtin_amdgcn_exp2f(a_[0]); a_[1] = __builtin_amdgcn_exp2f(a_[1]); b_[0] = __builtin_amdgcn_exp2f(b_[0]); b_[1] = __builtin_amdgcn_exp2f(b_[1]); \
        lacc = lacc + a_; lacc = lacc + b_; \
        pw[(e) >> 2][(e) & 3] = cvt_pk_bf16(a_[0], a_[1]); pw[2 + ((e) >> 2)][(e) & 3] = cvt_pk_bf16(b_[0], b_[1]); } while (0)
#define ATT_KRD(dst0, dst1, kb, d0) do { dst0 = *(const LAS bf16x8*)((kb) + (d0) * 2048); dst1 = *(const LAS bf16x8*)((kb) + (d0) * 2048 + 512); } while (0)
#define ATT_VRD(i, vb) do { vlo[(i) % 3] = vtr((vb) + ((i) % NDB) * 4096 + ((i) / NDB) * 1024); vhi[(i) % 3] = vtr((vb) + ((i) % NDB) * 4096 + ((i) / NDB) * 1024 + 512); } while (0)
#define ATT_STEP(PC0, PC1, MXC, PN0, PN1, MXN, t, HASQK) do { \
        constexpr bool sm_ = true; constexpr bool qk_ = (HASQK); \
        ATT_RESC(PC0, PC1, MXC); \
        if ((t) + 2 < nt) ATT_STOREK((t) & 1); \
        if ((t) + 1 < nt) ATT_STOREV(((t) + 1) & 1); \
        if ((t) + 3 < nt) ATT_LOADK((t) + 3); \
        if ((t) + 2 < nt) ATT_LOADV((t) + 2); \
        const bool zm_ = FILLM ? (bool)__all(mrow == 0.f) : true; (void)zm_; \
        { const LAS unsigned char* kb = lds + KB0 + (((t) + 1) & 1) * KBSZ + hi * 1024 + r32 * 16; \
          bf16x8 kc0, kc1, kn0, kn1; kn0 = kc0 = qf[0]; kn1 = kc1 = qf[0]; \
          if (qk_) ATT_KRD(kc0, kc1, kb, 0); \
          ATT_SB(); \
          _Pragma("unroll") for (int d0 = 0; d0 < ND0; ++d0) { \
              if (qk_ && d0 + 1 < ND0) ATT_KRD(kn0, kn1, kb, d0 + 1); \
              if (qk_) { if constexpr (FILLM) { if (d0 == 0) { if (zm_) { PN0 = __builtin_amdgcn_mfma_f32_32x32x16_bf16(kc0, qf[0], zero16, 0, 0, 0); } \
                                                                else { _Pragma("unroll") for (int r = 0; r < 16; ++r) { PN0[r] = -mrow; PN1[r] = -mrow; } PN0 = __builtin_amdgcn_mfma_f32_32x32x16_bf16(kc0, qf[0], PN0, 0, 0, 0); } } \
                                                 else PN0 = __builtin_amdgcn_mfma_f32_32x32x16_bf16(kc0, qf[d0], PN0, 0, 0, 0); } \
                         else PN0 = __builtin_amdgcn_mfma_f32_32x32x16_bf16(kc0, qf[d0], d0 == 0 ? negm : PN0, 0, 0, 0); } \
              if (sm_ && 2 * d0 < 8) ATT_EXPP(PC0, PC1, 2 * d0); \
              ATT_SB(); \
              if (qk_) { if constexpr (FILLM) { if (d0 == 0) { if (zm_) { PN1 = __builtin_amdgcn_mfma_f32_32x32x16_bf16(kc1, qf[0], zero16, 0, 0, 0); } \
                                                                else { PN1 = __builtin_amdgcn_mfma_f32_32x32x16_bf16(kc1, qf[0], PN1, 0, 0, 0); } } \
                                                 else PN1 = __builtin_amdgcn_mfma_f32_32x32x16_bf16(kc1, qf[d0], PN1, 0, 0, 0); } \
                         else PN1 = __builtin_amdgcn_mfma_f32_32x32x16_bf16(kc1, qf[d0], d0 == 0 ? negm : PN1, 0, 0, 0); } \
              if (sm_ && 2 * d0 + 1 < 8) ATT_EXPP(PC0, PC1, 2 * d0 + 1); \
              ATT_SB(); \
              kc0 = kn0; kc1 = kn1; } \
        } \
        { const LAS unsigned char* vb = lds + VB0 + ((t) & 1) * VBSZ + vlane_off; \
          s16x4 vlo[3], vhi[3]; float ma_ = -1e30f, mb_ = -1e30f; \
          if (sm_) { ATT_VRD(0, vb); ATT_VRD(1, vb); } \
          __builtin_amdgcn_s_setprio(1);        \
          ATT_SB(); \
          _Pragma("unroll") for (int i = 0; i < 4 * NDB; ++i) { \
              if (sm_ && i + 2 < 4 * NDB) ATT_VRD(i + 2, vb); \
              if (sm_) { const bf16x8 vf_ = (bf16x8){vlo[i % 3][0], vlo[i % 3][1], vlo[i % 3][2], vlo[i % 3][3], vhi[i % 3][0], vhi[i % 3][1], vhi[i % 3][2], vhi[i % 3][3]}; \
                  o[i % NDB] = __builtin_amdgcn_mfma_f32_32x32x16_bf16(__builtin_bit_cast(bf16x8, pw[i / NDB]), vf_, o[i % NDB], 0, 0, 0); } \
              if (qk_ && i < 8) { ma_ = max3f(ma_, PN0[2 * i], PN0[2 * i + 1]); mb_ = max3f(mb_, PN1[2 * i], PN1[2 * i + 1]); } \
              ATT_SB(); } \
          __builtin_amdgcn_s_setprio(0); \
          MXN = __builtin_fmaxf(ma_, mb_); } \
        __syncthreads(); } while (0)
#define ATT_STEP_DIL(PC0, PC1, MXC, PN0, PN1, MXN, t, HASQK) do { \
        const bool sm_ = ATT_NEED(t), qk_ = (HASQK) && ATT_NEED((t) + 1); \
        if (sm_) ATT_RESC(PC0, PC1, MXC); \
        if ((t) + 2 < nt) ATT_STOREK((t) & 1); \
        if ((t) + 1 < nt) ATT_STOREV(((t) + 1) & 1); \
        if ((t) + 3 < nt) ATT_LOADK((t) + 3); \
        if ((t) + 2 < nt) ATT_LOADV((t) + 2); \
        MXN = -1e30f; \
        if (qk_) { const LAS unsigned char* kb = lds + KB0 + (((t) + 1) & 1) * KBSZ + hi * 1024 + r32 * 16; \
            _Pragma("unroll") for (int d0 = 0; d0 < ND0; ++d0) { bf16x8 k0_, k1_; ATT_KRD(k0_, k1_, kb, d0); \
                PN0 = __builtin_amdgcn_mfma_f32_32x32x16_bf16(k0_, qf[d0], d0 == 0 ? (NEGM ? negm : zero16) : PN0, 0, 0, 0); \
                PN1 = __builtin_amdgcn_mfma_f32_32x32x16_bf16(k1_, qf[d0], d0 == 0 ? (NEGM ? negm : zero16) : PN1, 0, 0, 0); } \
            const int kvb_ = kv_lo + ((t) + 1) * 64; float a_ = -1e30f, b_ = -1e30f; \
            _Pragma("unroll") for (int r = 0; r < 16; ++r) { const int k0p = kvb_ + crow(r, hi), k1p = k0p + 32; const int e0_ = k0p - qrow, e1_ = k1p - qrow; \
                if (!((k0p >= 0) && (k0p < nseq) && (e0_ <= 64) && (e0_ >= -64))) PN0[r] = -1e30f; \
                if (!((k1p >= 0) && (k1p < nseq) && (e1_ <= 64) && (e1_ >= -64))) PN1[r] = -1e30f; \
                a_ = __builtin_fmaxf(a_, PN0[r]); b_ = __builtin_fmaxf(b_, PN1[r]); } \
            MXN = __builtin_fmaxf(a_, b_); } \
        if (sm_) { \
            _Pragma("unroll") for (int e = 0; e < 8; ++e) ATT_EXPP(PC0, PC1, e); \
            const LAS unsigned char* vb = lds + VB0 + ((t) & 1) * VBSZ + vlane_off; \
            _Pragma("unroll") for (int i = 0; i < 4 * NDB; ++i) { \
                const s16x4 lo_ = vtr(vb + (i % NDB) * 4096 + (i / NDB) * 1024), hh_ = vtr(vb + (i % NDB) * 4096 + (i / NDB) * 1024 + 512); \
                const bf16x8 vf_ = (bf16x8){lo_[0], lo_[1], lo_[2], lo_[3], hh_[0], hh_[1], hh_[2], hh_[3]}; \
                o[i % NDB] = __builtin_amdgcn_mfma_f32_32x32x16_bf16(__builtin_bit_cast(bf16x8, pw[i / NDB]), vf_, o[i % NDB], 0, 0, 0); } } \
        __syncthreads(); } while (0)
    f32x16 pa0, pa1, pb0, pb1; float mxa = -1e30f, mxb = -1e30f; u32x4 pw[4];
    pa0 = zero16; pa1 = zero16; pb0 = zero16; pb1 = zero16;
#pragma unroll
    for (int i = 0; i < 4; ++i) pw[i] = (u32x4){0u, 0u, 0u, 0u};
    ATT_LOADK(0); ATT_STOREK(0); ATT_LOADK(1); ATT_LOADV(0);
    __syncthreads();
    ATT_STOREK(1); ATT_STOREV(0); ATT_LOADK(2); ATT_LOADV(1);
    if (ATT_NEED(0)) { const LAS unsigned char* kb = lds + KB0 + hi * 1024 + r32 * 16;
#pragma unroll
        for (int d0 = 0; d0 < ND0; ++d0) { bf16x8 k0_, k1_; ATT_KRD(k0_, k1_, kb, d0);
            pa0 = __builtin_amdgcn_mfma_f32_32x32x16_bf16(k0_, qf[d0], d0 == 0 ? zero16 : pa0, 0, 0, 0);
            pa1 = __builtin_amdgcn_mfma_f32_32x32x16_bf16(k1_, qf[d0], d0 == 0 ? zero16 : pa1, 0, 0, 0); }
        if constexpr (DIL) { const int kvb_ = kv_lo;
#pragma unroll
            for (int r = 0; r < 16; ++r) { const int k0p = kvb_ + crow(r, hi), k1p = k0p + 32; const int e0_ = k0p - qrow, e1_ = k1p - qrow;
                if (!((k0p >= 0) && (k0p < nseq) && (e0_ <= 64) && (e0_ >= -64))) pa0[r] = -1e30f;
                if (!((k1p >= 0) && (k1p < nseq) && (e1_ <= 64) && (e1_ >= -64))) pa1[r] = -1e30f; } }
        float a_ = -1e30f, b_ = -1e30f;
#pragma unroll
        for (int i = 0; i < 8; ++i) { a_ = max3f(a_, pa0[2 * i], pa0[2 * i + 1]); b_ = max3f(b_, pa1[2 * i], pa1[2 * i + 1]); }
        mxa = __builtin_fmaxf(a_, b_);
    }
    __syncthreads();
    if constexpr (DIL) {
        for (int t = 0; t < nt; t += 2) {
            ATT_STEP_DIL(pa0, pa1, mxa, pb0, pb1, mxb, t, true);
            ATT_STEP_DIL(pb0, pb1, mxb, pa0, pa1, mxa, t + 1, (t + 2 < nt));
        }
    } else {
        for (int t = 0; t + 2 < nt; t += 2) {
            ATT_STEP(pa0, pa1, mxa, pb0, pb1, mxb, t, true);
            ATT_STEP(pb0, pb1, mxb, pa0, pa1, mxa, t + 1, true);
        }
        ATT_STEP(pa0, pa1, mxa, pb0, pb1, mxb, nt - 2, true);
        ATT_STEP(pb0, pb1, mxb, pa0, pa1, mxa, nt - 1, false);
    }
#undef ATT_STEP_DIL
#undef ATT_LOADK
#undef ATT_LOADV
#undef ATT_STOREK
#undef ATT_STOREV
#undef ATT_NEED
#undef ATT_SB
#undef ATT_RESC
#undef ATT_EXPP
#undef ATT_KRD
#undef ATT_VRD
#undef ATT_STEP
    const float lsum = lacc[0] + lacc[1];
    const float ltot = lsum + __shfl_xor(lsum, 32);
    __builtin_amdgcn_wave_barrier();
    if (hi == 0) wsf[r32] = 1.f / ltot;
    __builtin_amdgcn_wave_barrier();
    bf16_t* Ow = O + (size_t)(q0 + wid * 32) * (size_t)(SO * dl);
#pragma unroll
    for (int g4 = 0; g4 < 4; ++g4) { const f32x4 fv = *(const LAS f32x4*)(wsf + 8 * g4 + 4 * hi);
#pragma unroll
        for (int i = 0; i < 4; ++i) { const int r = 4 * g4 + i, orow = crow(r, hi);
#pragma unroll
            for (int db = 0; db < NDB; ++db) { const float v = o[db][r] * fv[i]; Ow[(size_t)orow * (size_t)(SO * dl) + db * 32 + r32] = (bf16_t)(cvt_pk_bf16(v, v) & 0xffffu); } } }
    if constexpr (DIL) { if (hi == 0) L[(size_t)qrow * (size_t)(4 * dl)] = (mrow + __log2f(ltot)) * 0.6931471805599453f; }
    __builtin_amdgcn_wave_barrier();
}
}

constexpr int NWAVES = 8, NTHREADS = 512;
constexpr int LDS_BYTES = 147456;
constexpr int XB_LDS_OFF = LDS_BYTES - 64;
struct Args { const float* in[18]; float* out; unsigned char* ws; int lo, hi; };

__device__ __forceinline__ float wave_sum(float v) {
#pragma unroll
    for (int o = 1; o < 64; o <<= 1) v += __shfl_xor(v, o);
    return v;
}
__device__ __forceinline__ unsigned f2bf(float f) { unsigned u = __builtin_bit_cast(unsigned, f); return (u + 0x7fffu + ((u >> 16) & 1u)) >> 16; }
__device__ __forceinline__ unsigned pk2(float lo, float hi) { return f2bf(lo) | (f2bf(hi) << 16); }

__device__ __forceinline__ int perm64(int p) { const int a = p >> 3, e = p & 7; return e < 4 ? 4 * a + e : 32 + 4 * a + (e - 4); }
__device__ __forceinline__ int perm32r(int p) { const int a = p >> 3, e = p & 7; return e < 4 ? 4 * a + e : 16 + 4 * a + (e - 4); }
__device__ __forceinline__ int inmap(int n) {
    if (n < 1024) return (n & ~63) + perm64(n & 63);
    if (n < 1536) return n;
    if (n < 3840) { const int r = n - 1536, g = r / 768, w = r % 768; if (w < 512) return 1536 + g * 768 + (w & ~63) + perm64(w & 63); return n; }
    if (n < 4864) return n;
    if (n < 4896) return 4864 + perm32r(n - 4864);
    if (n < 5120) return -1;
    return n - 5120 + 4896;
}
__device__ __forceinline__ int uqmap(int n) { if (n < 512) { return (n >> 6) * 96 + (n & 63); } const int r = n - 512; return (r >> 5) * 96 + 64 + perm32r(r & 31); }

__device__ __forceinline__ void prep_weight(const float* W, int K, int ldw, bf16_t* WT, int ndst, int kind, const float* sc, LAS float* scr, int gw, int NGW, int lane) {
    const int nblk = ndst / 32, nitems = (K / 64) * nblk;
    for (int item = gw; item < nitems; item += NGW) {
        const int kb = item / nblk, nb = item % nblk, k0 = 64 * kb, n0 = 32 * nb;
        const int nd = n0 + (lane & 31); const int src = kind == 0 ? nd : (kind == 1 ? inmap(nd) : uqmap(nd));
        float wv[32];
#pragma unroll
        for (int i = 0; i < 32; ++i) { const int kk = 2 * i + (lane >> 5); wv[i] = (src >= 0) ? W[(size_t)(k0 + kk) * ldw + src] : 0.f; }
#pragma unroll
        for (int i = 0; i < 32; ++i) { const int kk = 2 * i + (lane >> 5); float v = wv[i]; if (sc) v *= sc[k0 + kk]; scr[kk * 33 + (lane & 31)] = v; }
        asm volatile("s_waitcnt lgkmcnt(0)" ::: "memory"); __builtin_amdgcn_wave_barrier();
        const int c = lane & 7;
#pragma unroll
        for (int j = 0; j < 4; ++j) { const int n = (lane >> 3) + 8 * j; const LAS float* s = scr + (8 * c) * 33 + n;
            u32x4 o; o.x = pk2(s[0 * 33], s[1 * 33]); o.y = pk2(s[2 * 33], s[3 * 33]); o.z = pk2(s[4 * 33], s[5 * 33]); o.w = pk2(s[6 * 33], s[7 * 33]);
            *(u32x4*)(WT + (size_t)(n0 + n) * K + k0 + 8 * c) = o; }
        asm volatile("s_waitcnt lgkmcnt(0)" ::: "memory"); __builtin_amdgcn_wave_barrier();
    }
}

__device__ __forceinline__ void rows_to_bf16(const float* x, bf16_t* h, float* ssq, int gw, int NGW, int lane) {
    for (int m = gw; m < MH; m += NGW) {
        const f32x4* xr = (const f32x4*)(x + (size_t)m * DM) + lane;
        f32x4 v[4]; float s = 0.f;
#pragma unroll
        for (int j = 0; j < 4; ++j) { v[j] = xr[64 * j]; s += (v[j][0] * v[j][0] + v[j][1] * v[j][1]) + (v[j][2] * v[j][2] + v[j][3] * v[j][3]); }
        s = wave_sum(s);
        if (lane == 0) ssq[m] = s;
        u32x2* o8 = (u32x2*)(h + (size_t)m * DM) + lane;
#pragma unroll
        for (int j = 0; j < 4; ++j) { u32x2 w; w.x = pk2(v[j][0], v[j][1]); w.y = pk2(v[j][2], v[j][3]); o8[64 * j] = w; }
    }
}
__device__ __forceinline__ void zero_f32(float* p, int n, int gt, int NT_) { for (int i = gt; i < n; i += NT_) p[i] = 0.f; }

#define RLX_AGENT __ATOMIC_RELAXED, __HIP_MEMORY_SCOPE_AGENT
#define XB_TMO      128
#define XB_XCNT(j)  (256  + 64 * (j))
#define XB_XSUB(j)  (1280 + 64 * (j))
#define XB_XGEN(j)  (2304 + 64 * (j))
#define XB_TOP      3328
#define XB_TOPGEN   3392
#define XCD_BAR_WORDS 3456
#define XB_SPIN_CAP (1u << 18)

__device__ __forceinline__ unsigned xb_ld(unsigned* p)              { return __hip_atomic_load(p, __ATOMIC_RELAXED, __HIP_MEMORY_SCOPE_AGENT); }
__device__ __forceinline__ unsigned xb_add(unsigned* p, unsigned v) { return __hip_atomic_fetch_add(p, v, __ATOMIC_RELAXED, __HIP_MEMORY_SCOPE_AGENT); }
__device__ __forceinline__ unsigned xb_xcc_id() { return (unsigned)__builtin_amdgcn_s_getreg((3 << 11) | 20) & 0xFu; }
#define XB_SPIN(cond, bar) do { unsigned _sp = 0; while (cond) { __builtin_amdgcn_s_sleep(1); \
    if ((++_sp & 255u) == 0u) { if (xb_ld(&(bar)[XB_TMO])) break; if (_sp > XB_SPIN_CAP) { atomicAdd(&(bar)[XB_TMO], 1u); break; } } } } while (0)

struct XcdBarrier {
    unsigned* bar; unsigned x;
    volatile LAS unsigned* st;
};

__device__ __forceinline__ XcdBarrier xcd_barrier_post(unsigned* bar, volatile LAS unsigned* st) {
    XcdBarrier b; b.bar = bar; b.x = xb_xcc_id(); b.st = st;
    if (threadIdx.x == 0) (void)xb_add(&bar[XB_XCNT(b.x)], 1u);
    return b;
}
__device__ __forceinline__ void xcd_barrier_complete(unsigned* bar, unsigned x, unsigned& nloc, unsigned& nx) {
    const unsigned G = gridDim.x * gridDim.y * gridDim.z;
    unsigned sum, cnt, mine, sp = 0u;
    for (;;) {
        sum = 0u; cnt = 0u; mine = 0u;
#pragma unroll
        for (unsigned j = 0; j < 16; ++j) { const unsigned c = xb_ld(&bar[XB_XCNT(j)]); sum += c; cnt += (c > 0u) ? 1u : 0u; mine = (j == x) ? c : mine; }
        if (sum == G) break;
        __builtin_amdgcn_s_sleep(1);
        if ((++sp & 255u) == 0u) { if (xb_ld(&bar[XB_TMO])) break; if (sp > XB_SPIN_CAP) { atomicAdd(&bar[XB_TMO], 1u); break; } }
    }
    nloc = mine > 0u ? mine : 1u; nx = cnt > 0u ? cnt : 1u;
}

__device__ __forceinline__ void xcd_barrier(const XcdBarrier& b) {
    asm volatile("s_waitcnt vmcnt(0)" ::: "memory");
    __syncthreads();
    if (threadIdx.x == 0) {
        unsigned* bar = b.bar;
        __builtin_amdgcn_s_waitcnt(0);
        unsigned nloc = b.st[0], nx = b.st[1];
        if (nloc == 0u) { xcd_barrier_complete(bar, b.x, nloc, nx); b.st[0] = nloc; b.st[1] = nx; }
        const unsigned old = xb_add(&bar[XB_XSUB(b.x)], 1u);
        const unsigned gen = old / nloc;
        if (old + 1u == (gen + 1u) * nloc) {
            __builtin_amdgcn_fence(__ATOMIC_RELEASE, "agent");
            asm volatile("s_waitcnt vmcnt(0)" ::: "memory");
            const unsigned og = xb_add(&bar[XB_TOP], 1u);
            const unsigned tg = og / nx;
            if (og + 1u == (tg + 1u) * nx) xb_add(&bar[XB_TOPGEN], 1u);
            else XB_SPIN(xb_ld(&bar[XB_TOPGEN]) == tg, bar);
            __builtin_amdgcn_fence(__ATOMIC_ACQUIRE, "agent");
            xb_add(&bar[XB_XGEN(b.x)], 1u);
            asm volatile("s_waitcnt vmcnt(0)" ::: "memory");
        } else {
            XB_SPIN(xb_ld(&bar[XB_XGEN(b.x)]) == gen, bar);
            __builtin_amdgcn_fence(__ATOMIC_ACQUIRE, "agent");
            asm volatile("s_waitcnt vmcnt(0)" ::: "memory");
        }
    }
    __syncthreads();
}


constexpr int ST_PREP = 0, ST_PER = 10, NSTEPS = 1 + NHALF * DEPTH * ST_PER + 1;
#define WSP(T, off) ((T*)(ap->ws + (off)))
typedef const Args __attribute__((address_space(4))) * ArgsP;

__global__ void __launch_bounds__(NTHREADS, 2) mk_fwd(Args args) {
    extern __shared__ __attribute__((aligned(16))) unsigned char lds_raw[];
    LAS unsigned char* lds = (LAS unsigned char*)lds_raw;
    cg::grid_group grid = cg::this_grid();

    const int step_lo = args.lo, step_hi = args.hi;
    if (threadIdx.x < 2) ((volatile LAS unsigned*)(lds + XB_LDS_OFF))[threadIdx.x] = 0u;
    __syncthreads();
    if (step_hi - step_lo > 1) (void)xcd_barrier_post((unsigned*)(args.ws + WS_BAR), (volatile LAS unsigned*)(lds + XB_LDS_OFF));
    const int wave0 = __builtin_amdgcn_readfirstlane((int)threadIdx.x >> 6);
    for (int step = step_lo; step < step_hi; ++step) {
        ArgsP ap = (ArgsP)__builtin_amdgcn_kernarg_segment_ptr(); asm volatile("" : "+s"(ap));
        int wv_ = wave0; asm volatile("" : "+s"(wv_));
        int tid = wv_ * 64 + (int)__builtin_amdgcn_mbcnt_hi(~0u, __builtin_amdgcn_mbcnt_lo(~0u, 0u)); asm volatile("" : "+v"(tid));
        const int lane = tid & 63, wave = __builtin_amdgcn_readfirstlane(tid >> 6);
        int G = gridDim.x, bx = blockIdx.x; asm volatile("" : "+s"(G), "+s"(bx));
        const int vcu = (G % 8 == 0) ? (bx % 8) * (G / 8) + bx / 8 : bx;
        const int gw = vcu * NWAVES + wave, NGW = G * NWAVES;
        if (step == ST_PREP) {
            LAS float* scr = (LAS float*)(lds + wave * 16384);
            for (int l = 0; l < DEPTH; ++l) {
                unsigned char* wl = ap->ws + WS_W + (size_t)l * W_LAYER;
                prep_weight(ap->in[1] + (size_t)l * DM * INC, DM, INC, (bf16_t*)(wl + WO_IN), NIN, 1, ap->in[3] + l * DM, scr, gw, NGW, lane);
                prep_weight(ap->in[8] + (size_t)l * 768 * 768, 768, 768, (bf16_t*)(wl + WO_UQ), 768, 2, ap->in[6] + l * 768, scr, gw, NGW, lane);
                prep_weight(ap->in[9] + (size_t)l * 256 * 1024, 256, 1024, (bf16_t*)(wl + WO_UKV), 1024, 0, ap->in[7] + l * 256, scr, gw, NGW, lane);
                prep_weight(ap->in[10] + (size_t)l * 512 * DM, 512, DM, (bf16_t*)(wl + WO_OD), DM, 0, nullptr, scr, gw, NGW, lane);
                prep_weight(ap->in[11] + (size_t)l * 256 * DM, 256, DM, (bf16_t*)(wl + WO_OL), DM, 0, nullptr, scr, gw, NGW, lane);
                prep_weight(ap->in[12] + (size_t)l * 512 * DM, 512, DM, (bf16_t*)(wl + WO_OM), DM, 0, nullptr, scr, gw, NGW, lane);
                prep_weight(ap->in[13] + (size_t)l * DM * DM, DM, DM, (bf16_t*)(wl + WO_OUT), DM, 0, nullptr, scr, gw, NGW, lane);
                prep_weight(ap->in[15] + (size_t)l * DM * FF, DM, FF, (bf16_t*)(wl + WO_UP), FF, 0, ap->in[14] + l * DM, scr, gw, NGW, lane);
                prep_weight(ap->in[16] + (size_t)l * FF * DM, FF, DM, (bf16_t*)(wl + WO_DN), DM, 0, nullptr, scr, gw, NGW, lane);
            }
            const int gt = bx * NTHREADS + tid, NT_ = G * NTHREADS;
            float* cos64 = WSP(float, WS_COS64); float* sin64 = WSP(float, WS_SIN64); float* cos32 = WSP(float, WS_COS32); float* sin32 = WSP(float, WS_SIN32);
            for (int i = gt; i < SEQ * 32; i += NT_) { const int pos = i >> 5, j = i & 31;
                const float inv = powf(10000.f, -(float)j / 32.f); const float ang = (float)pos * inv;
                const double a = (double)ang; const double k = rint(a * 0.15915494309189535); const float r = (float)(a - k * 6.283185307179586);
                cos64[i] = cosf(r); sin64[i] = sinf(r); }
            for (int i = gt; i < SEQ * 16; i += NT_) { const int pos = i >> 4, j = i & 15;
                const float inv = powf(10000.f, -(float)j / 16.f); const float ang = (float)pos * inv;
                const double a = (double)ang; const double k = rint(a * 0.15915494309189535); const float r = (float)(a - k * 6.283185307179586);
                cos32[i] = cosf(r); sin32[i] = sinf(r); }
        } else if (step == NSTEPS - 1) {
            const float* gf = ap->in[17]; float* out = ap->out;
            for (int m = gw; m < MTOT; m += NGW) {
                f32x4* xr = (f32x4*)(out + (size_t)m * DM) + lane; const f32x4* gr = (const f32x4*)gf + lane;
                f32x4 v[4]; float s = 0.f;
#pragma unroll
                for (int j = 0; j < 4; ++j) { v[j] = xr[64 * j]; s += (v[j][0] * v[j][0] + v[j][1] * v[j][1]) + (v[j][2] * v[j][2] + v[j][3] * v[j][3]); }
                const float rstd = rsqrtf(wave_sum(s) * (1.f / DM) + EPS);
#pragma unroll
                for (int j = 0; j < 4; ++j) xr[64 * j] = v[j] * rstd * gr[64 * j];
            }
        } else {
            const int s1 = step - 1, hb = s1 / (DEPTH * ST_PER), l = (s1 / ST_PER) % DEPTH, ph = s1 % ST_PER;
            unsigned char* wl = ap->ws + WS_W + (size_t)l * W_LAYER;
            if (ph == 7 || (ph == 0 && l == 1)) continue;
            const int gt = bx * NTHREADS + tid, NT_ = G * NTHREADS;
            if (ph == 0) {
                rows_to_bf16(ap->in[0] + (size_t)hb * MH * DM, WSP(bf16_t, WS_H), WSP(float, WS_SSQ_X1), gw, NGW, lane);
                zero_f32(WSP(float, WS_SSQ_Q), MH, gt, NT_); zero_f32(WSP(float, WS_SSQ_KV), MH, gt, NT_);
            } else if (ph == 1) {
                pg8::Gemm g{WSP(bf16_t, WS_H), (const bf16_t*)(wl + WO_IN)};
                pg8::EpiInProj E{WSP(bf16_t, WS_P), ap->in[2] + (size_t)l * 3 * DM, WSP(float, WS_COS64), WSP(float, WS_SIN64), WSP(float, WS_COS32), WSP(float, WS_SIN32), WSP(float, WS_SSQ_Q), WSP(float, WS_SSQ_KV), WSP(float, WS_SSQ_X1)};
                pg8::gemm_phase<pg8::EpiInProj, true, MH, NIN, DM, DM, DM>(lds, tid, G, bx, g, E);
            } else if (ph == 2) {
                { pg8::Gemm g{WSP(bf16_t, WS_P) + PC_CQ, (const bf16_t*)(wl + WO_UQ)};
                  pg8::EpiUp E{WSP(bf16_t, WS_QC), 768, WSP(float, WS_SSQ_Q), 1.f / 768.f, 2, WSP(float, WS_COS32), WSP(float, WS_SIN32), 0.10206207261596577f * 1.4426950408889634f};
                  pg8::gemm_phase<pg8::EpiUp, true, MH, 768, 768, NIN, 768>(lds, tid, G, bx, g, E); }
                asm volatile("" : "+s"(ap));
                { pg8::Gemm g{WSP(bf16_t, WS_P) + PC_CKV, (const bf16_t*)(wl + WO_UKV)};
                  pg8::EpiUp E{WSP(bf16_t, WS_KVC), 1024, WSP(float, WS_SSQ_KV), 1.f / 256.f, -1, WSP(float, WS_COS32), WSP(float, WS_SIN32), 1.f};
                  pg8::gemm_phase<pg8::EpiUp, true, MH, 1024, 256, NIN, 256>(lds, tid, G, bx, g, E); }
                asm volatile("" : "+s"(ap));
            } else if (ph == 3) {
                zero_f32(WSP(float, WS_SSQ_X2), MH, gt, NT_); if (l == 0) zero_f32(WSP(float, WS_SSQ_X1), MH, gt, NT_);
                for (int u = vcu; u < 1024; u += G) {
                    const int b = u >> 8, mh = (u >> 5) & 7, qb = u & 31;
                    const bf16_t* pb = WSP(bf16_t, WS_P) + (size_t)b * SEQ * NIN;
                    att::attn_unit<64, 128, false, 1, NIN, 0, NIN, 0, NIN, DM>(pb + PC_DQ + mh * 64, nullptr, pb + PC_DK + mh * 64, nullptr, pb + PC_DV + (mh >> 1) * 128,
                        WSP(bf16_t, WS_OD) + (size_t)b * SEQ * DM + mh * 128, nullptr, qb * 256, 0, SEQ / 64, lds, tid);
                }
                for (int u = vcu; u < 1024; u += G) {
                    const int b = u >> 8, h = (u >> 5) & 7, qb = u & 31;
                    bf16_t* qb_ = WSP(bf16_t, WS_QC) + (size_t)b * SEQ * 768; const bf16_t* kb_ = WSP(bf16_t, WS_KVC) + (size_t)b * SEQ * 1024;
                    att::attn_unit<96, 64, false, 1, 768, 768, 1024, NIN, 1024, 768>(qb_ + h * 64, qb_ + 512 + h * 32, kb_ + h * 128, WSP(bf16_t, WS_P) + (size_t)b * SEQ * NIN + PC_KR, kb_ + h * 128 + 64,
                        qb_ + h * 64, nullptr, qb * 256, 0, SEQ / 64, lds, tid);
                }
                for (int u = vcu; u < 1536; u += G) {
                    const int b = u / 384, r = u % 384, h = r / 96, r2 = r % 96, g = r2 >> 5, w = r2 & 31;
                    const int dl = (g == 0) ? 1 : (g == 1 ? 4 : 16), nblk = 32 / dl, c = w / nblk, qb = w % nblk;
                    bf16_t* pb = WSP(bf16_t, WS_P) + ((size_t)b * SEQ + c) * NIN + PC_DIL + g * 768 + h * 64;
                    float* lp = WSP(float, WS_LSE) + (size_t)g * MH * 4 + ((size_t)b * SEQ + c) * 4 + h;
                    if (g == 0) att::attn_unit<64, 64, true, 1, NIN, 0, NIN, 0, NIN, NIN>(pb, nullptr, pb + 256, nullptr, pb + 512, pb, lp, qb * 256, qb * 256 - 64, 6, lds, tid);
                    else if (g == 1) att::attn_unit<64, 64, true, 4, NIN, 0, NIN, 0, NIN, NIN>(pb, nullptr, pb + 256, nullptr, pb + 512, pb, lp, qb * 256, qb * 256 - 64, 6, lds, tid);
                    else att::attn_unit<64, 64, true, 16, NIN, 0, NIN, 0, NIN, NIN>(pb, nullptr, pb + 256, nullptr, pb + 512, pb, lp, qb * 256, qb * 256 - 64, 6, lds, tid);
                }
            } else if (ph == 4) {
                const float* dlm = ap->in[4] + (size_t)l * 256; const float* gd = ap->in[5] + (size_t)l * 128;
                const float lam_init = 0.8f - 0.6f * expf(-0.3f * (float)l);
                const float s1_ = wave_sum(dlm[lane] * dlm[64 + lane]), s2_ = wave_sum(dlm[128 + lane] * dlm[192 + lane]);
                const float lam = expf(s1_) - expf(s2_) + lam_init;
                const int hh = lane >> 4, d8 = (lane & 15) * 8, d4 = (lane & 15) * 4;
                const bf16_t* OD = WSP(bf16_t, WS_OD); bf16_t* P = WSP(bf16_t, WS_P); const float* LSE = WSP(float, WS_LSE);
                const f32x4 gv0 = *(const f32x4*)(gd + d8) * (1.f - lam_init), gv1 = *(const f32x4*)(gd + d8 + 4) * (1.f - lam_init);
                for (int m0 = gw; m0 < MH; m0 += 2 * NGW) {
                    u32x4 w1[2], w2[2]; float lse[2][3]; u32x2 wv[2][3]; int mm[2];
#pragma unroll
                    for (int j = 0; j < 2; ++j) { const int m = (m0 + j * NGW < MH) ? m0 + j * NGW : m0; mm[j] = m;
                        w1[j] = *(const u32x4*)(OD + (size_t)m * DM + (2 * hh) * 128 + d8); w2[j] = *(const u32x4*)(OD + (size_t)m * DM + (2 * hh + 1) * 128 + d8);
#pragma unroll
                        for (int g = 0; g < 3; ++g) { lse[j][g] = LSE[(size_t)g * MH * 4 + (size_t)m * 4 + hh]; wv[j][g] = *(const u32x2*)(P + (size_t)m * NIN + PC_DIL + g * 768 + hh * 64 + d4); } }
#pragma unroll
                    for (int j = 0; j < 2; ++j) { const int m = mm[j]; if (j == 1 && m == m0) continue;
                        f32x4 ya, yb;
                        ya[0] = bf_lo(w1[j].x) - lam * bf_lo(w2[j].x); ya[1] = bf_hi(w1[j].x) - lam * bf_hi(w2[j].x); ya[2] = bf_lo(w1[j].y) - lam * bf_lo(w2[j].y); ya[3] = bf_hi(w1[j].y) - lam * bf_hi(w2[j].y);
                        yb[0] = bf_lo(w1[j].z) - lam * bf_lo(w2[j].z); yb[1] = bf_hi(w1[j].z) - lam * bf_hi(w2[j].z); yb[2] = bf_lo(w1[j].w) - lam * bf_lo(w2[j].w); yb[3] = bf_hi(w1[j].w) - lam * bf_hi(w2[j].w);
                        float ss = (ya[0] * ya[0] + ya[1] * ya[1]) + (ya[2] * ya[2] + ya[3] * ya[3]) + (yb[0] * yb[0] + yb[1] * yb[1]) + (yb[2] * yb[2] + yb[3] * yb[3]);
                        ss += __shfl_xor(ss, 1); ss += __shfl_xor(ss, 2); ss += __shfl_xor(ss, 4); ss += __shfl_xor(ss, 8);
                        const float rstd = rsqrtf(ss * (1.f / 128.f) + EPS);
                        ya = ya * rstd * gv0; yb = yb * rstd * gv1;
                        u32x4 ow; ow.x = pk2(ya[0], ya[1]); ow.y = pk2(ya[2], ya[3]); ow.z = pk2(yb[0], yb[1]); ow.w = pk2(yb[2], yb[3]);
                        const float l0 = lse[j][0], l1 = lse[j][1], l2 = lse[j][2];
                        const float lm = fmaxf(l0, fmaxf(l1, l2)); const float e0 = __expf(l0 - lm), e1 = __expf(l1 - lm), e2 = __expf(l2 - lm); const float ri = 1.f / (e0 + e1 + e2);
                        const float a0 = e0 * ri, a1 = e1 * ri, a2 = e2 * ri;
                        const u32x2 wv0 = wv[j][0], wv1 = wv[j][1], wv2 = wv[j][2];
                        const float ob0 = a0 * bf_lo(wv0.x) + a1 * bf_lo(wv1.x) + a2 * bf_lo(wv2.x), ob1 = a0 * bf_hi(wv0.x) + a1 * bf_hi(wv1.x) + a2 * bf_hi(wv2.x);
                        const float ob2 = a0 * bf_lo(wv0.y) + a1 * bf_lo(wv1.y) + a2 * bf_lo(wv2.y), ob3 = a0 * bf_hi(wv0.y) + a1 * bf_hi(wv1.y) + a2 * bf_hi(wv2.y);
                        *(u32x4*)(P + (size_t)m * NIN + PC_DQ + hh * 128 + d8) = ow;
                        u32x2 o2; o2.x = pk2(ob0, ob1); o2.y = pk2(ob2, ob3); *(u32x2*)(P + (size_t)m * NIN + PC_DIL + hh * 64 + d4) = o2; }
                }
            } else if (ph == 5) {
                { pg8::Gemm g{WSP(bf16_t, WS_P) + PC_DQ, (const bf16_t*)(wl + WO_OD)}; pg8::EpiMerge<true> E{WSP(bf16_t, WS_MB), WSP(bf16_t, WS_P) + PC_GATE};
                  pg8::gemm_phase<pg8::EpiMerge<true>, true, MH, DM, 512, NIN, 512>(lds, tid, G, bx, g, E); }
                asm volatile("" : "+s"(ap));
                { pg8::Gemm g{WSP(bf16_t, WS_P) + PC_DIL, (const bf16_t*)(wl + WO_OL)}; pg8::EpiMerge<false> E{WSP(bf16_t, WS_MB), WSP(bf16_t, WS_P) + PC_GATE + DM};
                  pg8::gemm_phase<pg8::EpiMerge<false>, true, MH, DM, 256, NIN, 256>(lds, tid, G, bx, g, E); }
                asm volatile("" : "+s"(ap));
                { pg8::Gemm g{WSP(bf16_t, WS_QC), (const bf16_t*)(wl + WO_OM)}; pg8::EpiMerge<false> E{WSP(bf16_t, WS_MB), WSP(bf16_t, WS_P) + PC_GATE + 2 * DM};
                  pg8::gemm_phase<pg8::EpiMerge<false>, true, MH, DM, 512, 768, 512>(lds, tid, G, bx, g, E); }
                asm volatile("" : "+s"(ap));
            } else if (ph == 6) {
                pg8::Gemm g{WSP(bf16_t, WS_MB), (const bf16_t*)(wl + WO_OUT)};
                pg8::EpiResid<true> E{(l == 0 ? ap->in[0] : ap->out) + (size_t)hb * MH * DM, ap->out + (size_t)hb * MH * DM, WSP(bf16_t, WS_H), WSP(float, WS_SSQ_X2)};
                pg8::gemm_phase<pg8::EpiResid<true>, true, MH, DM, DM, DM, DM>(lds, tid, G, bx, g, E);
            } else if (ph == 8) {
                pg8::Gemm g{WSP(bf16_t, WS_H), (const bf16_t*)(wl + WO_UP)};
                zero_f32(WSP(float, WS_SSQ_Q), MH, gt, NT_); zero_f32(WSP(float, WS_SSQ_KV), MH, gt, NT_);
                pg8::EpiSqRelu E{WSP(bf16_t, WS_P), FF, WSP(float, WS_SSQ_X2)};
                pg8::gemm_phase<pg8::EpiSqRelu, true, MH, FF, DM, DM, DM>(lds, tid, G, bx, g, E);
            } else {
                pg8::Gemm g{WSP(bf16_t, WS_P), (const bf16_t*)(wl + WO_DN)};
                if (l == 0) { pg8::EpiResid<true> E{ap->out + (size_t)hb * MH * DM, ap->out + (size_t)hb * MH * DM, WSP(bf16_t, WS_H), WSP(float, WS_SSQ_X1)};
                              pg8::gemm_phase<pg8::EpiResid<true>, true, MH, DM, FF, FF, FF>(lds, tid, G, bx, g, E); }
                else        { pg8::EpiResid<false> E{ap->out + (size_t)hb * MH * DM, ap->out + (size_t)hb * MH * DM, nullptr, nullptr};
                              pg8::gemm_phase<pg8::EpiResid<false>, true, MH, DM, FF, FF, FF>(lds, tid, G, bx, g, E); }
            }
        }
        if (step + 1 < step_hi) { if (step_lo < 0) grid.sync(); else { XcdBarrier xb_; xb_.bar = WSP(unsigned, WS_BAR); xb_.x = xb_xcc_id(); xb_.st = (volatile LAS unsigned*)(lds + XB_LDS_OFF); xcd_barrier(xb_); } }
    }
}

extern "C" void kernel_launch(void* const* d_in, const int* in_sizes, int n_in, void* d_out, int out_size, void* d_ws, size_t ws_size, hipStream_t stream) {
    static int grid = 0;
    if (grid == 0) {
        if (n_in != 18 || out_size != MTOT * DM || ws_size < WS_END) { fprintf(stderr, "kernel_launch: unexpected shapes (n_in %d out %d ws %zu)\n", n_in, out_size, ws_size); grid = -1; return; }
        int dev = 0, cus = 0, per_cu = 0;
        (void)hipGetDevice(&dev); (void)hipDeviceGetAttribute(&cus, hipDeviceAttributeMultiprocessorCount, dev);
        if (hipFuncSetAttribute((const void*)mk_fwd, hipFuncAttributeMaxDynamicSharedMemorySize, LDS_BYTES) != hipSuccess) { fprintf(stderr, "hipFuncSetAttribute failed\n"); grid = -1; return; }
        (void)hipOccupancyMaxActiveBlocksPerMultiprocessor(&per_cu, (const void*)mk_fwd, NTHREADS, LDS_BYTES);
        (void)hipGetLastError();
        if (per_cu < 1) per_cu = 1;
        grid = cus * 1;
        fprintf(stderr, "kernel_launch: grid %d (occupancy query %d/CU)\n", grid, per_cu);
    }
    if (grid < 0) return;
    if (hipMemsetAsync((char*)d_ws + WS_BAR, 0, 16384, stream) != hipSuccess) { fprintf(stderr, "kernel_launch: hipMemsetAsync failed\n"); return; }
    Args a{};
    for (int i = 0; i < 18; ++i) a.in[i] = (const float*)d_in[i];
    a.out = (float*)d_out; a.ws = (unsigned char*)d_ws;
#if MK_MULTI
    for (int s = 0; s < NSTEPS; ++s) { a.lo = s; a.hi = s + 1; void* kargs[] = {&a};
        hipError_t e = hipLaunchCooperativeKernel((const void*)mk_fwd, dim3(grid), dim3(NTHREADS), kargs, LDS_BYTES, stream);
        if (e != hipSuccess) { fprintf(stderr, "launch step %d failed: %s\n", s, hipGetErrorString(e)); break; } }
#else
    a.lo = 0; a.hi = NSTEPS; void* kargs[] = {&a};
    hipError_t e = hipLaunchCooperativeKernel((const void*)mk_fwd, dim3(grid), dim3(NTHREADS), kargs, LDS_BYTES, stream);
    if (e != hipSuccess) fprintf(stderr, "cooperative launch failed: %s (grid %d)\n", hipGetErrorString(e), grid);
#endif
}
```
